# Optimizing an MI355X kernel written in HIP

```python
import jax, jax.numpy as jnp
from jax import lax
import numpy as np

D_MODEL = 2048
BATCH = 8
SEQ = 4096
DEPTH = 1

HEAD_DIM = 128
ROPE_THETA = 10000.0
NSA_HEADS = 8
NSA_KV_GROUPS = 2
NSA_REP = NSA_HEADS // NSA_KV_GROUPS
CMP_LEN = 32
CMP_STRIDE = 16
CMP_HIDDEN = 256
SEL_LEN = 64
SEL_TOPK = 16
WIN_LEN = 512
SEL_QUERY_CHUNK = 64
BAND_BLOCK = 128
DIL_CONFIGS = ((128, 1), (512, 4), (2048, 16))
N_DIL = 3
DIL_HEADS = 4
N_EXPERTS = 32
TOP_K = 4
D_EXPERT = D_MODEL
SWIGLU_LIMIT = 7.0
SWIGLU_ALPHA = 1.702
MOE_BLOCK = 128
DN_ALPHA = (2.0 * DEPTH) ** 0.25
DN_BETA = (8.0 * DEPTH) ** -0.25
LN_EPS = 1e-5
NEG = -1e30
FORCE = 1e9
NSA_Q_W = NSA_HEADS * HEAD_DIM
NSA_KV_W = NSA_KV_GROUPS * HEAD_DIM
NSA_GATE_W = 3 * NSA_HEADS
DIL_GROUP_W = DIL_HEADS * HEAD_DIM
IN_W = NSA_Q_W + 6 * NSA_KV_W + NSA_GATE_W + 3 * N_DIL * DIL_GROUP_W + 2 * D_MODEL

kernel_name = "hybrid_nsa_dilated_moe_deepnorm"


def layer_norm(x, g, b):
    xf = x.astype(jnp.float32)
    mu = xf.mean(-1, keepdims=True)
    var = jnp.square(xf - mu).mean(-1, keepdims=True)
    return ((xf - mu) * lax.rsqrt(var + LN_EPS) * g + b).astype(x.dtype)


def rope_tables(seq):
    pos = jnp.arange(seq, dtype=jnp.float32)
    inv = ROPE_THETA ** (-jnp.arange(0, HEAD_DIM, 2, dtype=jnp.float32) / HEAD_DIM)
    ang = pos[:, None] * inv[None, :]
    return jnp.cos(ang), jnp.sin(ang)


def apply_rope(x, cos, sin):
    half = HEAD_DIM // 2
    c = cos[:, None, :].astype(x.dtype)
    s = sin[:, None, :].astype(x.dtype)
    x1, x2 = x[..., :half], x[..., half:]
    return jnp.concatenate([x1 * c - x2 * s, x2 * c + x1 * s], axis=-1)


def masked_softmax(scores, mask):
    s = jnp.where(mask, scores, NEG)
    m = s.max(-1, keepdims=True)
    p = jnp.where(mask, jnp.exp(s - m), 0.0)
    den = p.sum(-1, keepdims=True)
    safe = jnp.where(den > 0, den, 1.0)
    return p / safe, (m + jnp.log(safe))[..., 0]


def banded_attention(q, k, v, max_dist, blk):
    B, L, G, R, Dh = q.shape
    n_prev = -(-max_dist // blk)
    nb = -(-L // blk)
    pad = nb * blk - L
    q = jnp.pad(q, ((0, 0), (0, pad), (0, 0), (0, 0), (0, 0)))
    k = jnp.pad(k, ((0, 0), (n_prev * blk, pad), (0, 0), (0, 0)))
    v = jnp.pad(v, ((0, 0), (n_prev * blk, pad), (0, 0), (0, 0)))
    qb = q.reshape(B, nb, blk, G, R, Dh)
    kw = jnp.concatenate([k[:, i * blk:(i + nb) * blk].reshape(B, nb, blk, G, Dh) for i in range(n_prev + 1)], axis=2)
    vw = jnp.concatenate([v[:, i * blk:(i + nb) * blk].reshape(B, nb, blk, G, Dh) for i in range(n_prev + 1)], axis=2)
    nk = (n_prev + 1) * blk
    qi = jnp.arange(blk)[:, None]
    ki = jnp.arange(nk)[None, :]
    diff = n_prev * blk + qi - ki
    k_pos = (jnp.arange(nb)[:, None, None] - n_prev) * blk + ki[None]
    mask = (diff >= 0)[None] & (diff <= max_dist)[None] & (k_pos >= 0)
    s = jnp.einsum("bnqgrd,bnkgd->bngrqk", qb, kw).astype(jnp.float32) * (Dh ** -0.5)
    p, lse = masked_softmax(s, mask[None, :, None, None])
    o = jnp.einsum("bngrqk,bnkgd->bnqgrd", p.astype(vw.dtype), vw)
    o = o.reshape(B, nb * blk, G, R, Dh)[:, :L]
    lse = lse.transpose(0, 1, 4, 2, 3).reshape(B, nb * blk, G, R)[:, :L]
    return o, lse


def nsa_attention(q, k_c, v_c, k_s, v_s, k_w, v_w, gate_logits, pos_k, pos_v, ck_w1, ck_w2, cv_w1, cv_w2):
    B, S, G, R, Dh = q.shape
    scale = Dh ** -0.5
    t = jnp.arange(S)
    n_cmp = (S - CMP_LEN) // CMP_STRIDE + 1
    c_start = jnp.arange(n_cmp) * CMP_STRIDE
    idx = c_start[:, None] + jnp.arange(CMP_LEN)[None, :]

    def compress(src, pos, w1, w2):
        blocks = src[:, idx] + pos[None, None, :, None, :]
        flat = blocks.transpose(0, 1, 3, 2, 4).reshape(B, n_cmp, G, CMP_LEN * Dh)
        return jax.nn.gelu(flat @ w1) @ w2

    kc = compress(k_c, pos_k, ck_w1, ck_w2)
    vc = compress(v_c, pos_v, cv_w1, cv_w2)
    s_cmp = jnp.einsum("bsgrd,bcgd->bgrsc", q, kc).astype(jnp.float32) * scale
    mask_cmp = (c_start + CMP_LEN - 1)[None, :] <= t[:, None]
    p_cmp, _ = masked_softmax(s_cmp, mask_cmp)
    o_cmp = jnp.einsum("bgrsc,bcgd->bsgrd", p_cmp.astype(vc.dtype), vc)
    n_slc = S // SEL_LEN
    j = jnp.arange(n_slc)
    overlap = (c_start[:, None] < (j[None, :] + 1) * SEL_LEN) & (c_start[:, None] + CMP_LEN > j[None, :] * SEL_LEN)
    imp = jnp.einsum("bgrsc,cj->bgsj", p_cmp, overlap.astype(jnp.float32))
    cur = t // SEL_LEN
    forced = (j[None, :] == 0) | (j[None, :] == cur[:, None]) | (j[None, :] == cur[:, None] - 1)
    future = j[None, :] > cur[:, None]
    imp = jnp.where(forced, FORCE, jnp.where(future, NEG, imp))
    n_sel = min(SEL_TOPK, n_slc)
    _, sel = lax.top_k(imp, n_sel)
    kb = k_s.reshape(B, n_slc, SEL_LEN, G, Dh).transpose(0, 3, 1, 2, 4)
    vb = v_s.reshape(B, n_slc, SEL_LEN, G, Dh).transpose(0, 3, 1, 2, 4)
    qc_len = SEL_QUERY_CHUNK
    nq = S // qc_len
    q_ch = q.reshape(B, nq, qc_len, G, R, Dh).transpose(1, 0, 2, 3, 4, 5)
    sel_ch = sel.reshape(B, G, nq, qc_len, n_sel).transpose(2, 0, 1, 3, 4)
    pos_ch = t.reshape(nq, qc_len)
    bi = jnp.arange(B)[:, None, None, None]
    gi = jnp.arange(G)[None, :, None, None]
    nk = n_sel * SEL_LEN

    def sel_block(args):
        qc, sc, pc = args
        kg = kb[bi, gi, sc].reshape(B, G, qc_len, nk, Dh)
        vg = vb[bi, gi, sc].reshape(B, G, qc_len, nk, Dh)
        kpos = (sc[..., None] * SEL_LEN + jnp.arange(SEL_LEN)).reshape(B, G, qc_len, nk)
        mask = (kpos <= pc[None, None, :, None])[:, :, None]
        s = jnp.einsum("bqgrd,bgqkd->bgrqk", qc, kg).astype(jnp.float32) * scale
        p, _ = masked_softmax(s, mask)
        return jnp.einsum("bgrqk,bgqkd->bqgrd", p.astype(vg.dtype), vg)

    o_slc = lax.map(sel_block, (q_ch, sel_ch, pos_ch))
    o_slc = o_slc.transpose(1, 0, 2, 3, 4, 5).reshape(B, S, G, R, Dh)
    o_win, _ = banded_attention(q, k_w, v_w, WIN_LEN - 1, BAND_BLOCK)
    g = jax.nn.sigmoid(gate_logits)
    return g[..., 0:1] * o_cmp + g[..., 1:2] * o_slc + g[..., 2:3] * o_win


def dilated_attention(qs, ks, vs):
    outs, lses = [], []
    for (w, d), q, k, v in zip(DIL_CONFIGS, qs, ks, vs):
        B, S, H, Dh = q.shape
        ls = S // d

        def to_sub(a):
            return a.reshape(B, ls, d, H, Dh).transpose(0, 2, 1, 3, 4).reshape(B * d, ls, H, Dh)

        o, lse = banded_attention(to_sub(q)[:, :, :, None], to_sub(k), to_sub(v), w // d, BAND_BLOCK)
        outs.append(o[:, :, :, 0].reshape(B, d, ls, H, Dh).transpose(0, 2, 1, 3, 4).reshape(B, S, H, Dh))
        lses.append(lse[..., 0].reshape(B, d, ls, H).transpose(0, 2, 1, 3).reshape(B, S, H))
    wts = jax.nn.softmax(jnp.stack(lses), axis=0)
    return jnp.einsum("gbsh,gbshd->bshd", wts.astype(outs[0].dtype), jnp.stack(outs))


def hybrid_mixer(x, w_in, b_in, pos_k, pos_v, ck_w1, ck_w2, cv_w1, cv_w2, w_br_nsa, w_br_dil, w_out):
    B, S, _ = x.shape
    proj = x @ w_in + b_in
    sizes = [NSA_Q_W] + [NSA_KV_W] * 6 + [NSA_GATE_W] + [DIL_GROUP_W] * (3 * N_DIL) + [D_MODEL, D_MODEL]
    offs, acc = [], 0
    for sz in sizes[:-1]:
        acc += sz
        offs.append(acc)
    parts = jnp.split(proj, offs, axis=-1)
    cos, sin = rope_tables(S)

    def heads(a):
        return a.reshape(B, S, -1, HEAD_DIM)

    def rope(a):
        return apply_rope(heads(a), cos, sin)

    q_n = rope(parts[0]).reshape(B, S, NSA_KV_GROUPS, NSA_REP, HEAD_DIM)
    k_c, k_s, k_w = rope(parts[1]), rope(parts[3]), rope(parts[5])
    v_c, v_s, v_w = heads(parts[2]), heads(parts[4]), heads(parts[6])
    gl = parts[7].reshape(B, S, NSA_KV_GROUPS, NSA_REP, 3)
    o_nsa = nsa_attention(q_n, k_c, v_c, k_s, v_s, k_w, v_w, gl, pos_k, pos_v, ck_w1, ck_w2, cv_w1, cv_w2)
    dil = parts[8:8 + 3 * N_DIL]
    o_dil = dilated_attention([rope(dil[3 * i]) for i in range(N_DIL)],
                              [rope(dil[3 * i + 1]) for i in range(N_DIL)],
                              [heads(dil[3 * i + 2]) for i in range(N_DIL)])
    gate_a, gate_b = parts[8 + 3 * N_DIL], parts[9 + 3 * N_DIL]
    y_a = o_nsa.reshape(B, S, -1) @ w_br_nsa
    y_b = o_dil.reshape(B, S, -1) @ w_br_dil
    merged = jax.nn.sigmoid(gate_a) * y_a + jax.nn.sigmoid(gate_b) * y_b
    return merged @ w_out


def clamped_swiglu(hu):
    glu, lin = jnp.split(hu, 2, axis=-1)
    glu = jnp.minimum(glu, SWIGLU_LIMIT)
    lin = jnp.clip(lin, -SWIGLU_LIMIT, SWIGLU_LIMIT)
    return glu * jax.nn.sigmoid(SWIGLU_ALPHA * glu) * (lin + 1.0)


def moe(h, w_router, b_router, w_up, b_up, w_down, b_down):
    B, S, D = h.shape
    T = B * S
    hf = h.reshape(T, D)
    logits = (hf @ w_router + b_router).astype(jnp.float32)
    top_vals, top_idx = lax.top_k(logits, TOP_K)
    gates = jax.nn.softmax(top_vals, axis=-1)
    A = T * TOP_K
    e_flat = top_idx.reshape(A)
    tok_flat = jnp.arange(A) // TOP_K
    w_flat = gates.reshape(A)
    order = jnp.argsort(e_flat)
    e_sorted, tok_sorted, w_sorted = e_flat[order], tok_flat[order], w_flat[order]
    counts = jnp.bincount(e_flat, length=N_EXPERTS)
    starts = jnp.cumsum(counts) - counts
    padded = (counts + MOE_BLOCK - 1) // MOE_BLOCK * MOE_BLOCK
    pad_end = jnp.cumsum(padded)
    pad_start = pad_end - padded
    dest = pad_start[e_sorted] + (jnp.arange(A) - starts[e_sorted])
    P = A + N_EXPERTS * MOE_BLOCK
    n_blk = P // MOE_BLOCK
    buf_tok = jnp.full((P,), T, dtype=jnp.int32).at[dest].set(tok_sorted.astype(jnp.int32))
    buf_w = jnp.zeros((P,), jnp.float32).at[dest].set(w_sorted)
    blk_expert = jnp.minimum(jnp.searchsorted(pad_end, jnp.arange(n_blk) * MOE_BLOCK, side="right"), N_EXPERTS - 1)
    h_pad = jnp.concatenate([hf, jnp.zeros((1, D), hf.dtype)], axis=0)
    xb = h_pad[buf_tok].reshape(n_blk, MOE_BLOCK, D)

    def expert_block(args):
        xblk, e = args
        hu = xblk @ w_up[e] + b_up[e]
        return clamped_swiglu(hu) @ w_down[e] + b_down[e]

    yb = lax.map(expert_block, (xb, blk_expert))
    y = yb.reshape(P, D) * buf_w[:, None].astype(yb.dtype)
    out = jax.ops.segment_sum(y, buf_tok, num_segments=T + 1)[:T]
    return out.reshape(B, S, D)


def setup_inputs(seed: int = 0) -> dict:
    key = jax.random.key(seed)
    ks = jax.random.split(key, 22)
    L = DEPTH

    def nrm(k, shape, scale):
        return jax.random.normal(k, shape, jnp.float32) * scale

    return {
        "x": nrm(ks[0], (BATCH, SEQ, D_MODEL), 1.0),
        "w_in": nrm(ks[1], (L, D_MODEL, IN_W), D_MODEL ** -0.5),
        "b_in": nrm(ks[2], (L, IN_W), 0.01),
        "cmp_pos_k": nrm(ks[3], (L, CMP_LEN, HEAD_DIM), 0.1),
        "cmp_pos_v": nrm(ks[4], (L, CMP_LEN, HEAD_DIM), 0.1),
        "cmp_k_w1": nrm(ks[5], (L, CMP_LEN * HEAD_DIM, CMP_HIDDEN), (CMP_LEN * HEAD_DIM) ** -0.5),
        "cmp_k_w2": nrm(ks[6], (L, CMP_HIDDEN, HEAD_DIM), CMP_HIDDEN ** -0.5),
        "cmp_v_w1": nrm(ks[7], (L, CMP_LEN * HEAD_DIM, CMP_HIDDEN), (CMP_LEN * HEAD_DIM) ** -0.5),
        "cmp_v_w2": nrm(ks[8], (L, CMP_HIDDEN, HEAD_DIM), CMP_HIDDEN ** -0.5),
        "w_br_nsa": nrm(ks[9], (L, NSA_HEADS * HEAD_DIM, D_MODEL), (NSA_HEADS * HEAD_DIM) ** -0.5),
        "w_br_dil": nrm(ks[10], (L, DIL_HEADS * HEAD_DIM, D_MODEL), (DIL_HEADS * HEAD_DIM) ** -0.5),
        "w_out": nrm(ks[11], (L, D_MODEL, D_MODEL), D_MODEL ** -0.5 * DN_BETA),
        "ln1_g": 1.0 + nrm(ks[12], (L, D_MODEL), 0.02),
        "ln1_b": nrm(ks[13], (L, D_MODEL), 0.02),
        "w_router": nrm(ks[14], (L, D_MODEL, N_EXPERTS), D_MODEL ** -0.5),
        "b_router": nrm(ks[15], (L, N_EXPERTS), 0.01),
        "w_up": nrm(ks[16], (L, N_EXPERTS, D_MODEL, 2 * D_EXPERT), D_MODEL ** -0.5),
        "b_up": nrm(ks[17], (L, N_EXPERTS, 2 * D_EXPERT), 0.01),
        "w_down": nrm(ks[18], (L, N_EXPERTS, D_EXPERT, D_MODEL), D_EXPERT ** -0.5 * DN_BETA),
        "b_down": nrm(ks[19], (L, N_EXPERTS, D_MODEL), 0.01),
        "ln2_g": 1.0 + nrm(ks[20], (L, D_MODEL), 0.02),
        "ln2_b": nrm(ks[21], (L, D_MODEL), 0.02),
    }


def reference(x, w_in, b_in, cmp_pos_k, cmp_pos_v, cmp_k_w1, cmp_k_w2, cmp_v_w1, cmp_v_w2,
              w_br_nsa, w_br_dil, w_out, ln1_g, ln1_b, w_router, b_router, w_up, b_up,
              w_down, b_down, ln2_g, ln2_b):
    h = x
    for l in range(DEPTH):
        mix = hybrid_mixer(h, w_in[l], b_in[l], cmp_pos_k[l], cmp_pos_v[l], cmp_k_w1[l], cmp_k_w2[l],
                           cmp_v_w1[l], cmp_v_w2[l], w_br_nsa[l], w_br_dil[l], w_out[l])
        h = layer_norm(DN_ALPHA * h + mix, ln1_g[l], ln1_b[l])
        ffn = moe(h, w_router[l], b_router[l], w_up[l], b_up[l], w_down[l], b_down[l])
        h = layer_norm(DN_ALPHA * h + ffn, ln2_g[l], ln2_b[l])
    return h
```

```cpp
#include <hip/hip_runtime.h>
#include <cstdio>
#include <cstdint>
#include <cmath>

constexpr int NB = 8, S_ = 4096, DM = 2048, T_ = NB * S_, HD = 128;
constexpr int IN_W = 11288, LDP = 11520;
constexpr int C_QN = 0, C_KC = 1024, C_VC = 1280, C_KS = 1536, C_VS = 1792, C_KW = 2048, C_VW = 2304;
constexpr int C_DIL = 2560;
constexpr int C_GA = 7168, C_GB = 9216, C_GL = 11264;
constexpr int NEXP = 32, TOPK = 4, MOE_ROWS = T_ * TOPK + NEXP * 256, MOE_TILES = MOE_ROWS / 256;
constexpr float DN_ALPHA = 1.189207115002721f;
constexpr float LN_EPS = 1e-5f;
constexpr float ATT_SCALE = 0.08838834764831845f;

__host__ __device__ __forceinline__ int wcol_of(int c) {
    if (c < 2560) return c;
    if (c < 11264) return c + 24;
    if (c < 11288) return c - 11264 + 2560;
    return -1;
}
__host__ __device__ __forceinline__ bool is_rope_tile(int pn) { return pn < 5 || pn == 6 || pn == 8 || (pn >= 10 && pn < 28 && ((pn - 10) % 6) < 4); }
__host__ __device__ __forceinline__ int inproj_phys2log(int pn, int p) { if (!is_rope_tile(pn)) return p; const int bj = p >> 7, hl = (p >> 6) & 1, d = p & 63; return hl * 128 + bj * 64 + d; }

typedef unsigned short bf16_t;
typedef short bf16x8 __attribute__((ext_vector_type(8)));
typedef float f32x4 __attribute__((ext_vector_type(4)));
typedef float f32x16 __attribute__((ext_vector_type(16)));
typedef unsigned u32x4 __attribute__((ext_vector_type(4)));
typedef unsigned u32x2 __attribute__((ext_vector_type(2)));
#define LAS __attribute__((address_space(3)))
#define GAS __attribute__((address_space(1)))

__device__ __forceinline__ float bf2f(bf16_t v) { return __uint_as_float((unsigned)v << 16); }
__device__ __forceinline__ unsigned cvt_pk_bf16(float lo, float hi) { unsigned r; asm volatile("v_cvt_pk_bf16_f32 %0, %1, %2" : "=v"(r) : "v"(lo), "v"(hi)); return r; }
__device__ __forceinline__ float sigm(float x) { return 1.f / (1.f + expf(-x)); }
__device__ __forceinline__ float sigm_fast(float x) { return __builtin_amdgcn_rcpf(1.f + __builtin_amdgcn_exp2f(-1.4426950408889634f * x)); }
__device__ __forceinline__ float gelu_tanh(float x) { return 0.5f * x * (1.f + tanhf(0.7978845608028654f * (x + 0.044715f * x * x * x))); }
__device__ __forceinline__ int tid_of(int wave) { int l; asm volatile("v_mbcnt_lo_u32_b32 %0, -1, 0\n\tv_mbcnt_hi_u32_b32 %0, -1, %0" : "=v"(l)); return (wave << 6) | l; }
__device__ __forceinline__ float wave_sum(float v) { for (int o = 1; o < 64; o <<= 1) v += __shfl_xor(v, o); return v; }

constexpr size_t MiB = 1ull << 20;
constexpr size_t WS_CTL = 0;
constexpr size_t WS_ROPE = 1 * MiB;
constexpr size_t WS_KC = 3 * MiB;
constexpr size_t WS_VC = 5 * MiB;
constexpr size_t WS_SELM = 7 * MiB;
constexpr size_t WS_ROUTE = 8 * MiB;
constexpr size_t WS_LSE = 12 * MiB;
constexpr size_t WS_BINP = 14 * MiB;
constexpr size_t WS_BUPP = WS_BINP + 64 * 1024;
constexpr size_t WS_KCB = 15 * MiB;
constexpr size_t WS_VCB = 16 * MiB;
constexpr size_t WS_W = 20 * MiB;
constexpr size_t WS_WIN = WS_W;
constexpr size_t WS_WBA = WS_WIN + 45 * MiB;
constexpr size_t WS_WBD = WS_WBA + 4 * MiB;
constexpr size_t WS_WOUT = WS_WBD + 2 * MiB;
constexpr size_t WS_CW1 = WS_WOUT + 8 * MiB;
constexpr size_t WS_CW2 = WS_CW1 + 4 * MiB;
constexpr size_t WS_WUP = WS_CW2 + 1 * MiB;
constexpr size_t WS_WDN = WS_WUP + 512 * MiB;
constexpr size_t WS_XB = WS_WDN + 256 * MiB;
constexpr size_t WS_PROJ = WS_XB + 128 * MiB;
constexpr size_t WS_ONSA = WS_PROJ + 720 * MiB;
constexpr size_t WS_ODP = WS_ONSA + 128 * MiB;
constexpr size_t WS_ODIL = WS_ODP + 192 * MiB;
constexpr size_t WS_MERGED = WS_ODIL + 64 * MiB;
constexpr size_t WS_Z = WS_MERGED + 256 * MiB;
constexpr size_t WS_HB = WS_Z + 256 * MiB;
constexpr size_t PJ_QN = 0;
constexpr size_t PJ_KV = 64 * MiB;
constexpr size_t PJ_DIL = 160 * MiB;
constexpr size_t PJ_GA = 448 * MiB;
constexpr size_t PJ_GB = 576 * MiB;
constexpr size_t PJ_GL = 704 * MiB;
__host__ __device__ __forceinline__ int dil_row(int cfg, int t) { const int dl = 2 * cfg; return ((t & ((1 << dl) - 1)) << (12 - dl)) + (t >> dl); }
constexpr size_t WS_ONSAB = WS_ONSA;
constexpr size_t WS_ODILB = WS_ODIL;
constexpr size_t WS_SCR = WS_MERGED + 128 * MiB;
constexpr size_t WS_POSB = WS_BUPP + 512 * 1024;
constexpr size_t WS_ACT = WS_PROJ;
constexpr size_t WS_Y = WS_HB + 128 * MiB;
constexpr size_t WS_WRT = WS_POSB + 64 * 1024;
constexpr size_t WS_H = WS_Y + 600 * MiB;
constexpr size_t WS_END = WS_Y + 1088 * MiB;
static_assert(WS_END <= 4096 * MiB, "ws map");
constexpr int CW_CNT = 64;
constexpr int CW_NTILES = 128;
constexpr int CW_PADSTART = 192;
constexpr int CW_TILEEXP = 256;
constexpr int CW_TEST = 960;
constexpr int CW_QUEUE = 1024;
constexpr int CW_BAR = 4096;

struct Args { const float* in[22]; float* out; unsigned char* ws; int ph_lo, ph_hi, li, pad; };
typedef Args P;
#ifndef F8_EXPERIMENT
#define F8_EXPERIMENT 0
#endif
namespace pg8 {
typedef int v4i_t __attribute__((ext_vector_type(4)));
typedef int v8i_t __attribute__((ext_vector_type(8)));
#define PG8_LAS __attribute__((address_space(3)))
constexpr int BM = 256, BK = 64, HALF = 128, HTB = HALF * BK * 2, STAGE_BYTES = 8 * HTB, NXCD = 8, WGM = 8;
__host__ __device__ __forceinline__ int lds_byte(int r, int c) { const int st = (r >> 4) * 2 + (c >> 5), rr = r & 15, cc = c & 31, ob = rr * 64 + cc * 2; return st * 1024 + (ob ^ (((ob >> 9) & 1) << 5)); }
__host__ __device__ __forceinline__ void stage_rc(int b, int& R, int& C) { const int st = b / 1024, sb = b % 1024, swz = sb ^ (((sb >> 9) & 1) << 5); R = (st >> 1) * 16 + swz / 64; C = (st & 1) * 32 + (swz % 64) / 2; }
__host__ __device__ __forceinline__ int perm32(int rho) { const int n = rho >> 4, i = rho & 15; return 8 * (i >> 2) + 4 * n + (i & 3); }

struct Unit { int pm, pn, pb; };
struct Gemm { const bf16_t* A; const bf16_t* Bt; int K; const int* arows; const bf16_t* A2 = nullptr; const bf16_t* Bt2 = nullptr; int K2 = 0; };

struct StaticOrder {
    int nM, nN, nwg, G, c;
    __device__ void init(int nM_, int nN_, int G_, int c_) { nM = nM_; nN = nN_; nwg = nM * nN; G = G_; c = c_; }
    __device__ bool next(int i, Unit& u) const {
        const long L = (long)i * G + c; if (L >= nwg) return false;
        int wgid = (int)L; { const int q = nwg / NXCD, r = nwg % NXCD, xcd = wgid % NXCD, off = wgid / NXCD; wgid = (xcd < r ? xcd * (q + 1) : r * (q + 1) + (xcd - r) * q) + off; }
        const int nig = WGM * nN, gid = wgid / nig, fm = gid * WGM, gsz = (nM - fm) < WGM ? (nM - fm) : WGM;
        u.pm = fm + ((wgid % nig) % gsz); u.pn = (wgid % nig) / gsz; u.pb = u.pn; return true;
    }
};
struct ExpertOrderRev {
    StaticOrder so; const PG8_LAS unsigned* tile_exp;
    __device__ bool next(int i, Unit& u) const { if (!so.next(i, u)) return false; u.pm = so.nM - 1 - u.pm; u.pb = (int)tile_exp[u.pm] * so.nN + u.pn; return true; }
};
struct ExpertOrder {
    StaticOrder so; const PG8_LAS unsigned* tile_exp;
    __device__ bool next(int i, Unit& u) const { if (!so.next(i, u)) return false; u.pb = (int)tile_exp[u.pm] * so.nN + u.pn; return true; }
};

template <class Epi, class Sched, bool GATHER, bool F8 = false, bool SEG2 = false>
__device__ __forceinline__ void gemm_phase(PG8_LAS unsigned char* lds, const Gemm g, const Sched& S, const Epi& E, const int wid) {
    const int tid = tid_of(wid), lane = tid & 63, wr = wid >> 2, wc = wid & 3, fr = lane & 15, fq = lane >> 4;
    const int K = g.K, RB = F8 ? K : K * 2, nt1 = F8 ? K / 128 : K / BK, RB2 = SEG2 ? g.K2 * 2 : RB, nt = SEG2 ? nt1 + g.K2 / BK : nt1;
    unsigned voffA[2], voffB[2], voffA2[2], voffB2[2]; int rA[2], cA2[2];
#pragma unroll
    for (int i = 0; i < 2; ++i) { int R, CB;
        { int C; stage_rc(tid * 16 + i * 8192, R, C); CB = C * 2; }
        const int Rb = (R & ~31) + perm32(R & 31);
        voffA[i] = (unsigned)(R * RB + CB); voffB[i] = (unsigned)(Rb * RB + CB); voffA2[i] = (unsigned)(R * RB2 + CB); voffB2[i] = (unsigned)(Rb * RB2 + CB); rA[i] = R; cA2[i] = CB; }
    const size_t kstep = 128;
    const size_t hstep = (size_t)HALF * RB;
    const size_t tstep = 2 * hstep;
    const size_t hstep2 = (size_t)HALF * RB2, tstep2 = 2 * hstep2;
    const unsigned ldsw = (unsigned)wid * 1024u;
    const int aoff = lds_byte(wr * 64 + fr, fq * 8), boff = lds_byte(wc * 32 + fr, fq * 8);
#define PG8_SA(b, h) (((b) * 2 + (h)) * HTB)
#define PG8_SB(b, h) ((4 + (b) * 2 + (h)) * HTB)
#define PG8_STAGE(bufoff, gbase, voff) do { _Pragma("unroll") for (int _i = 0; _i < 2; ++_i) \
        __builtin_amdgcn_global_load_lds((const unsigned*)((const char*)(gbase) + (voff)[_i]), (PG8_LAS unsigned*)(lds + (bufoff) + ldsw + _i * 8192), 16, 0, 0); } while (0)
#define PG8_STAGE_A(bufoff, gbase, h, par) do { if constexpr (GATHER) { unsigned vg_[2]; _Pragma("unroll") for (int _i = 0; _i < 2; ++_i) vg_[_i] = rowtab[(par) * 256 + (h) * HALF + rA[_i]] * (unsigned)RB + (unsigned)cA2[_i]; PG8_STAGE(bufoff, gbase, vg_); } \
        else { PG8_STAGE(bufoff, (gbase) + (h) * hstep, voffA); } } while (0)
#define PG8_STAGE_AX(bufoff, gbase, h, par, HS, VO) do { if constexpr (GATHER) { PG8_STAGE_A(bufoff, gbase, h, par); } else { PG8_STAGE(bufoff, (gbase) + (h) * (HS), VO); } } while (0)
#define PG8_LDA(dst, b, h) do { _Pragma("unroll") for (int m = 0; m < 4; ++m) { dst[m].lo = *(const PG8_LAS v4i_t*)(lds + PG8_SA(b, h) + aoff + m * 2048); dst[m].hi = *(const PG8_LAS v4i_t*)(lds + PG8_SA(b, h) + aoff + m * 2048 + 1024); } } while (0)
#define PG8_LDB(dst, b, h) do { _Pragma("unroll") for (int n = 0; n < 2; ++n) { dst[n].lo = *(const PG8_LAS v4i_t*)(lds + PG8_SB(b, h) + boff + n * 2048); dst[n].hi = *(const PG8_LAS v4i_t*)(lds + PG8_SB(b, h) + boff + n * 2048 + 1024); } } while (0)
#define PG8_MMA(ai, bj, At, Bt) do { __builtin_amdgcn_s_setprio(1); _Pragma("unroll") for (int m = 0; m < 4; ++m) _Pragma("unroll") for (int n = 0; n < 2; ++n) { \
        if constexpr (F8) { if (F8_EXPERIMENT == 2) { _Pragma("unroll") for (int q = 0; q < 4; ++q) { \
                u32x4 bw, aw; _Pragma("unroll") for (int hh = 0; hh < 2; ++hh) { \
                    const auto b0 = __builtin_amdgcn_cvt_pk_f32_fp8(Bt[n][2 * q + hh], false), b1 = __builtin_amdgcn_cvt_pk_f32_fp8(Bt[n][2 * q + hh], true); \
                    const auto a0 = __builtin_amdgcn_cvt_pk_f32_fp8(At[m][2 * q + hh], false), a1 = __builtin_amdgcn_cvt_pk_f32_fp8(At[m][2 * q + hh], true); \
                    bw[2 * hh] = cvt_pk_bf16(b0[0], b0[1]); bw[2 * hh + 1] = cvt_pk_bf16(b1[0], b1[1]); aw[2 * hh] = cvt_pk_bf16(a0[0], a0[1]); aw[2 * hh + 1] = cvt_pk_bf16(a1[0], a1[1]); } \
                acc[ai][bj][m][n] = __builtin_amdgcn_mfma_f32_16x16x32_bf16(__builtin_bit_cast(bf16x8, bw), __builtin_bit_cast(bf16x8, aw), acc[ai][bj][m][n], 0, 0, 0); } } \
            else if (F8_EXPERIMENT == 1) { _Pragma("unroll") for (int q = 0; q < 4; ++q) { \
                const long bq = ((long)(unsigned)Bt[n][2 * q + 1] << 32) | (unsigned)Bt[n][2 * q], aq = ((long)(unsigned)At[m][2 * q + 1] << 32) | (unsigned)At[m][2 * q]; \
                acc[ai][bj][m][n] = __builtin_amdgcn_mfma_f32_16x16x32_fp8_fp8(bq, aq, acc[ai][bj][m][n], 0, 0, 0); } } \
            else asm volatile("v_mfma_f32_16x16x128_f8f6f4 %0, %1, %2, %0" : "+v"(acc[ai][bj][m][n]) : "v"(Bt[n]), "v"(At[m])); } \
        else { const v4i_t bl_ = Bt[n].lo, bh_ = Bt[n].hi, al_ = At[m].lo, ah_ = At[m].hi;     \
               acc[ai][bj][m][n] = __builtin_amdgcn_mfma_f32_16x16x32_bf16(__builtin_bit_cast(bf16x8, bl_), __builtin_bit_cast(bf16x8, al_), acc[ai][bj][m][n], 0, 0, 0); \
               acc[ai][bj][m][n] = __builtin_amdgcn_mfma_f32_16x16x32_bf16(__builtin_bit_cast(bf16x8, bh_), __builtin_bit_cast(bf16x8, ah_), acc[ai][bj][m][n], 0, 0, 0); } } \
        __builtin_amdgcn_s_setprio(0); } while (0)
#define PG8_WAIT_V(n) asm volatile("s_waitcnt vmcnt(" #n ")" ::: "memory")
#define PG8_WAIT_L(n) asm volatile("s_waitcnt lgkmcnt(" #n ")" ::: "memory")
#define PG8_BAR __builtin_amdgcn_s_barrier()
#define PG8_SCHED __builtin_amdgcn_sched_barrier(0)
    Unit cur, nxt; int ui = 0;
    if (!S.next(0, cur)) return;
    f32x4 acc[2][2][4][2];
#pragma unroll
    for (int a = 0; a < 2; ++a)
#pragma unroll
        for (int b = 0; b < 2; ++b)
#pragma unroll
            for (int m = 0; m < 4; ++m)
#pragma unroll
                for (int n = 0; n < 2; ++n) acc[a][b][m][n] = (f32x4){0.f, 0.f, 0.f, 0.f};
    v8i_t At[4], B0[2], B1[2];
    const PG8_LAS unsigned* rowtab = (const PG8_LAS unsigned*)(lds + STAGE_BYTES + 4096);
#define PG8_ROWTAB_FILL(u, par) do { if constexpr (GATHER) { if (wid < 4) __builtin_amdgcn_global_load_lds((const unsigned*)(g.arows + (u).pm * BM + wid * 64 + lane), (PG8_LAS unsigned*)(lds + STAGE_BYTES + 4096 + (par) * 1024 + wid * 256), 4, 0, 0); } } while (0)
    if constexpr (GATHER) { PG8_ROWTAB_FILL(cur, 0); PG8_WAIT_V(0); PG8_BAR; }
    const char* cA = GATHER ? (const char*)g.A : (const char*)g.A + (size_t)cur.pm * tstep; const char* cB = (const char*)g.Bt + (size_t)cur.pb * tstep;
    const char* cAs = SEG2 ? (const char*)g.A2 + (size_t)cur.pm * tstep2 : cA; const char* cBs = SEG2 ? (const char*)g.Bt2 + (size_t)cur.pb * tstep2 : cB;
    PG8_STAGE(PG8_SB(0, 0), cB, voffB); PG8_STAGE(PG8_SB(0, 1), cB + hstep, voffB); PG8_STAGE_A(PG8_SA(0, 0), cA, 0, 0); PG8_STAGE_A(PG8_SA(0, 1), cA, 1, 0);
    if (wr == 1) PG8_BAR;
    PG8_WAIT_V(2); PG8_BAR;
    PG8_STAGE(PG8_SB(1, 0), cB + kstep, voffB); PG8_STAGE_A(PG8_SA(1, 0), cA + kstep, 0, 0); PG8_STAGE(PG8_SB(1, 1), cB + hstep + kstep, voffB);
    PG8_WAIT_V(6); PG8_BAR;
    for (;;) {
        const bool has_next = S.next(ui + 1, nxt);
        const int parc = ui & 1;
        if (has_next) PG8_ROWTAB_FILL(nxt, parc ^ 1);
        const char* nA = GATHER ? (const char*)g.A : (has_next ? (const char*)g.A + (size_t)nxt.pm * tstep : cA); const char* nB = has_next ? (const char*)g.Bt + (size_t)nxt.pb * tstep : cB;
        for (int t = 0; t < nt; t += 2) {
            const bool last = (t == nt - 2);
            const bool c1 = SEG2 ? (t < nt1) : true, n1 = SEG2 ? (last || t + 2 < nt1) : true;
            const size_t hs_c = c1 ? hstep : hstep2, hs_n = n1 ? hstep : hstep2;
            unsigned vAc[2], vAn[2], vBn[2];
#pragma unroll
            for (int i = 0; i < 2; ++i) { vAc[i] = c1 ? voffA[i] : voffA2[i]; vAn[i] = n1 ? voffA[i] : voffA2[i]; vBn[i] = n1 ? voffB[i] : voffB2[i]; }
            const char* a1 = c1 ? cA + (size_t)(t + 1) * kstep : cAs + (size_t)(t + 1 - nt1) * kstep;
            const char* a2 = last ? nA : (n1 ? cA + (size_t)(t + 2) * kstep : cAs + (size_t)(t + 2 - nt1) * kstep); const char* b2 = last ? nB : (n1 ? cB + (size_t)(t + 2) * kstep : cBs + (size_t)(t + 2 - nt1) * kstep);
            const char* a3 = a2 + kstep; const char* b3 = b2 + kstep;
            if constexpr (SEG2) { if (t == nt1) { int fr_ = fr, fq_ = fq; asm volatile("" : "+v"(fr_), "+v"(fq_)); E.mid(acc, cur, wr, wc, fr_, fq_); } }
            const int par2 = (last && has_next) ? (parc ^ 1) : parc;
            PG8_LDB(B0, 0, 0); PG8_LDB(B1, 0, 1); PG8_SCHED; PG8_LDA(At, 0, 0); PG8_STAGE_AX(PG8_SA(1, 1), a1, 1, parc, hs_c, vAc);
            PG8_WAIT_V(8); PG8_WAIT_L(0); PG8_BAR; PG8_MMA(0, 0, At, B0); PG8_MMA(0, 1, At, B1); PG8_BAR; PG8_SCHED;
            PG8_LDA(At, 0, 1); PG8_STAGE(PG8_SB(0, 0), b2, vBn); PG8_STAGE(PG8_SB(0, 1), b2 + hs_n, vBn); PG8_STAGE_AX(PG8_SA(0, 0), a2, 0, par2, hs_n, vAn);
            PG8_WAIT_V(8); PG8_WAIT_L(0); PG8_BAR; PG8_MMA(1, 0, At, B0); PG8_MMA(1, 1, At, B1); PG8_BAR; PG8_SCHED;
            PG8_LDB(B0, 1, 0); PG8_LDB(B1, 1, 1); PG8_SCHED; PG8_LDA(At, 1, 0); PG8_STAGE_AX(PG8_SA(0, 1), a2, 1, par2, hs_n, vAn);
            PG8_WAIT_V(8); PG8_WAIT_L(0); PG8_BAR; PG8_MMA(0, 0, At, B0); PG8_MMA(0, 1, At, B1); PG8_BAR; PG8_SCHED;
            PG8_LDA(At, 1, 1); PG8_STAGE(PG8_SB(1, 0), b3, vBn); PG8_STAGE(PG8_SB(1, 1), b3 + hs_n, vBn); PG8_STAGE_AX(PG8_SA(1, 0), a3, 0, par2, hs_n, vAn);
            PG8_WAIT_V(8); PG8_WAIT_L(0); PG8_BAR; PG8_MMA(1, 0, At, B0); PG8_MMA(1, 1, At, B1); PG8_BAR; PG8_SCHED;
        }
        if (wr == 0) PG8_BAR;
        { int fr_ = fr, fq_ = fq; asm volatile("" : "+v"(fr_), "+v"(fq_)); E(acc, cur, wr, wc, fr_, fq_); }
        if (!has_next) break;
#pragma unroll
        for (int a = 0; a < 2; ++a)
#pragma unroll
            for (int b = 0; b < 2; ++b)
#pragma unroll
                for (int m = 0; m < 4; ++m)
#pragma unroll
                    for (int n = 0; n < 2; ++n) acc[a][b][m][n] = (f32x4){0.f, 0.f, 0.f, 0.f};
        cur = nxt; cA = nA; cB = nB; ++ui;
        if constexpr (SEG2) { cAs = (const char*)g.A2 + (size_t)cur.pm * tstep2; cBs = (const char*)g.Bt2 + (size_t)cur.pb * tstep2; }
        if (wr == 1) PG8_BAR;
    }
    PG8_WAIT_V(0);
    PG8_BAR;
#undef PG8_SA
#undef PG8_SB
#undef PG8_STAGE
#undef PG8_STAGE_A
#undef PG8_STAGE_AX
#undef PG8_LDA
#undef PG8_LDB
#undef PG8_MMA
#undef PG8_WAIT_V
#undef PG8_WAIT_L
#undef PG8_BAR
#undef PG8_SCHED
#undef PG8_ROWTAB_FILL
}

struct EpiInProj {
    unsigned char* pj; const float* biasp; const float* rc; const float* rs;
    __device__ __forceinline__ bf16_t* head_row(int pn, int hs, int b, int t) const {
        if (pn < 4) return (bf16_t*)(pj + PJ_QN) + ((size_t)(b * 8 + 2 * pn + hs) * S_ + t) * 128;
        if (pn < 10) return (bf16_t*)(pj + PJ_KV + (size_t)(pn - 4) * 16 * MiB) + ((size_t)(b * 2 + hs) * S_ + t) * 128;
        const int idx = pn - 10, cfg = idx / 6, part = (idx % 6) >> 1, half = idx & 1;
        return (bf16_t*)(pj + PJ_DIL + (size_t)(cfg * 3 + part) * 32 * MiB) + ((size_t)(b * 4 + 2 * half + hs) * S_ + dil_row(cfg, t)) * 128;
    }
    __device__ __forceinline__ void operator()(const f32x4 (&acc)[2][2][4][2], const Unit& u, int wr, int wc, int fr, int fq) const {
        const int pn = u.pn, pc = wc * 32 + fq * 8;
        const bool rope = is_rope_tile(pn), gate = pn >= 28;
        f32x4 bv[2][2];
#pragma unroll
        for (int bj = 0; bj < 2; ++bj)
#pragma unroll
            for (int n = 0; n < 2; ++n) bv[bj][n] = *(const f32x4*)(biasp + pn * 256 + bj * HALF + pc + 4 * n);
        if (rope) {
            const int hl = pc >> 6, d0 = pc & 63;
#pragma unroll
            for (int ai = 0; ai < 2; ++ai) {
                f32x4 C[4][2], S[4][2];
#pragma unroll
                for (int m = 0; m < 4; ++m) { const int t = (u.pm * BM + ai * HALF + wr * 64 + m * 16 + fr) & (S_ - 1);
#pragma unroll
                    for (int n = 0; n < 2; ++n) { C[m][n] = *(const f32x4*)(rc + t * 64 + d0 + 4 * n); S[m][n] = *(const f32x4*)(rs + t * 64 + d0 + 4 * n); } }
#pragma unroll
                for (int m = 0; m < 4; ++m) {
                    const int row = u.pm * BM + ai * HALF + wr * 64 + m * 16 + fr, t = row & (S_ - 1), b = row >> 12;
                    bf16_t* rowp = head_row(pn, hl, b, t) + d0;
                    u32x4 w1, w2;
#pragma unroll
                    for (int n = 0; n < 2; ++n) {
                        const f32x4 c = C[m][n], s = S[m][n];
                        const f32x4 x1 = acc[ai][0][m][n] + bv[0][n], x2 = acc[ai][1][m][n] + bv[1][n];
                        const f32x4 o1 = x1 * c - x2 * s, o2 = x2 * c + x1 * s;
                        w1[2 * n] = cvt_pk_bf16(o1[0], o1[1]); w1[2 * n + 1] = cvt_pk_bf16(o1[2], o1[3]);
                        w2[2 * n] = cvt_pk_bf16(o2[0], o2[1]); w2[2 * n + 1] = cvt_pk_bf16(o2[2], o2[3]);
                    }
                    *(u32x4*)rowp = w1; *(u32x4*)(rowp + 64) = w2;
                }
            }
        } else {
#pragma unroll
            for (int ai = 0; ai < 2; ++ai)
#pragma unroll
                for (int m = 0; m < 4; ++m) {
                    const int row = u.pm * BM + ai * HALF + wr * 64 + m * 16 + fr, t = row & (S_ - 1), b = row >> 12;
#pragma unroll
                    for (int bj = 0; bj < 2; ++bj) {
                        f32x4 v0 = acc[ai][bj][m][0] + bv[bj][0], v1 = acc[ai][bj][m][1] + bv[bj][1];
                        bf16_t* dst;
                        if (gate) {
#pragma unroll
                            for (int i = 0; i < 4; ++i) { v0[i] = sigm_fast(v0[i]); v1[i] = sigm_fast(v1[i]); }
                            if (pn < 36) dst = (bf16_t*)(pj + PJ_GA) + (size_t)row * DM + (pn - 28) * 256 + bj * HALF + pc;
                            else if (pn < 44) dst = (bf16_t*)(pj + PJ_GB) + (size_t)row * DM + (pn - 36) * 256 + bj * HALF + pc;
                            else dst = (bf16_t*)(pj + PJ_GL) + (size_t)row * 32 + pc;
                        } else dst = head_row(pn, bj, b, t) + pc;
                        u32x4 w; w.x = cvt_pk_bf16(v0[0], v0[1]); w.y = cvt_pk_bf16(v0[2], v0[3]); w.z = cvt_pk_bf16(v1[0], v1[1]); w.w = cvt_pk_bf16(v1[2], v1[3]);
                        if (pn < 44 || (bj == 0 && wc == 0)) *(u32x4*)dst = w;
                    }
                }
        }
    }
};
template <bool ACCUM> struct EpiBr {
    bf16_t* merged; const bf16_t* gbuf;
    __device__ __forceinline__ void operator()(const f32x4 (&acc)[2][2][4][2], const Unit& u, int wr, int wc, int fr, int fq) const {
        const int c0 = u.pn * BM + wc * 32 + fq * 8;
#pragma unroll
        for (int ai = 0; ai < 2; ++ai)
#pragma unroll
            for (int m = 0; m < 4; ++m) {
                const int row = u.pm * BM + ai * HALF + wr * 64 + m * 16 + fr;
#pragma unroll
                for (int bj = 0; bj < 2; ++bj) {
                    const u32x4 gw = *(const u32x4*)(gbuf + (size_t)row * DM + c0 + bj * HALF);
                    bf16_t* op = merged + (size_t)row * DM + c0 + bj * HALF;
                    u32x4 ow = {0u, 0u, 0u, 0u}; if (ACCUM) ow = *(const u32x4*)op;
                    u32x4 w;
#pragma unroll
                    for (int j = 0; j < 4; ++j) {
                        const f32x4& a = acc[ai][bj][m][j >> 1];
                        float v0 = __uint_as_float(gw[j] << 16) * a[(j & 1) * 2], v1 = __uint_as_float(gw[j] & 0xffff0000u) * a[(j & 1) * 2 + 1];
                        if (ACCUM) { v0 += __uint_as_float(ow[j] << 16); v1 += __uint_as_float(ow[j] & 0xffff0000u); }
                        w[j] = cvt_pk_bf16(v0, v1);
                    }
                    *(u32x4*)op = w;
                }
            }
    }
};
struct EpiBr2 {
    bf16_t* merged; const bf16_t* ga; const bf16_t* gb;
    __device__ __forceinline__ void mid(f32x4 (&acc)[2][2][4][2], const Unit& u, int wr, int wc, int fr, int fq) const {
        const int c0 = u.pn * BM + wc * 32 + fq * 8;
#pragma unroll
        for (int ai = 0; ai < 2; ++ai)
#pragma unroll
            for (int m = 0; m < 4; ++m) {
                const int row = u.pm * BM + ai * HALF + wr * 64 + m * 16 + fr;
#pragma unroll
                for (int bj = 0; bj < 2; ++bj) {
                    const u32x4 aw = *(const u32x4*)(ga + (size_t)row * DM + c0 + bj * HALF), bw = *(const u32x4*)(gb + (size_t)row * DM + c0 + bj * HALF);
#pragma unroll
                    for (int j = 0; j < 4; ++j) {
                        f32x4& a = acc[ai][bj][m][j >> 1];
                        a[(j & 1) * 2] *= __uint_as_float(aw[j] << 16) * __builtin_amdgcn_rcpf(fmaxf(__uint_as_float(bw[j] << 16), 1e-30f));
                        a[(j & 1) * 2 + 1] *= __uint_as_float(aw[j] & 0xffff0000u) * __builtin_amdgcn_rcpf(fmaxf(__uint_as_float(bw[j] & 0xffff0000u), 1e-30f));
                    }
                }
            }
    }
    __device__ __forceinline__ void operator()(const f32x4 (&acc)[2][2][4][2], const Unit& u, int wr, int wc, int fr, int fq) const {
        const int c0 = u.pn * BM + wc * 32 + fq * 8;
#pragma unroll
        for (int ai = 0; ai < 2; ++ai)
#pragma unroll
            for (int m = 0; m < 4; ++m) {
                const int row = u.pm * BM + ai * HALF + wr * 64 + m * 16 + fr;
#pragma unroll
                for (int bj = 0; bj < 2; ++bj) {
                    const u32x4 gw = *(const u32x4*)(gb + (size_t)row * DM + c0 + bj * HALF);
                    u32x4 w;
#pragma unroll
                    for (int j = 0; j < 4; ++j) {
                        const f32x4& a = acc[ai][bj][m][j >> 1];
                        w[j] = cvt_pk_bf16(__uint_as_float(gw[j] << 16) * a[(j & 1) * 2], __uint_as_float(gw[j] & 0xffff0000u) * a[(j & 1) * 2 + 1]);
                    }
                    *(u32x4*)(merged + (size_t)row * DM + c0 + bj * HALF) = w;
                }
            }
    }
};
struct EpiWout {
    bf16_t* u;
    __device__ __forceinline__ void operator()(const f32x4 (&acc)[2][2][4][2], const Unit& u_, int wr, int wc, int fr, int fq) const {
        const int c0 = u_.pn * BM + wc * 32 + fq * 8;
#pragma unroll
        for (int ai = 0; ai < 2; ++ai)
#pragma unroll
            for (int m = 0; m < 4; ++m) {
                const size_t off = (size_t)(u_.pm * BM + ai * HALF + wr * 64 + m * 16 + fr) * DM + c0;
#pragma unroll
                for (int bj = 0; bj < 2; ++bj) { const f32x4 v0 = acc[ai][bj][m][0], v1 = acc[ai][bj][m][1];
                    u32x4 w; w.x = cvt_pk_bf16(v0[0], v0[1]); w.y = cvt_pk_bf16(v0[2], v0[3]); w.z = cvt_pk_bf16(v1[0], v1[1]); w.w = cvt_pk_bf16(v1[2], v1[3]);
                    *(u32x4*)(u + off + bj * HALF) = w; }
            }
    }
};
struct EpiNull { __device__ __forceinline__ void operator()(const f32x4 (&acc)[2][2][4][2], const Unit& u, int wr, int wc, int fr, int fq) const {
    _Pragma("unroll") for (int a = 0; a < 2; ++a) _Pragma("unroll") for (int b = 0; b < 2; ++b) _Pragma("unroll") for (int m = 0; m < 4; ++m) _Pragma("unroll") for (int n = 0; n < 2; ++n) asm volatile("" :: "v"(acc[a][b][m][n])); } };
__device__ __forceinline__ unsigned f2e4m3(float v) {
    const unsigned s = (__float_as_uint(v) >> 24) & 0x80u;
    const float x = fminf(fabsf(v), 448.f);
    unsigned b = __float_as_uint(x); b += 0x7FFFFu + ((b >> 20) & 1u);
    const unsigned rn = (b >> 20) - 960u;
    const unsigned rs = (unsigned)__builtin_rintf(x * 512.f);
    return s | (x < 0.015625f ? rs : rn);
}
#ifndef SOFT_FP8
#define SOFT_FP8 0
#endif
__device__ __forceinline__ unsigned pk4_fp8(float a, float b, float c, float d) {
    if (SOFT_FP8) return f2e4m3(a) | (f2e4m3(b) << 8) | (f2e4m3(c) << 16) | (f2e4m3(d) << 24);
    int w = 0; w = __builtin_amdgcn_cvt_pk_fp8_f32(a, b, w, false); w = __builtin_amdgcn_cvt_pk_fp8_f32(c, d, w, true); return (unsigned)w; }
template <bool OUT8> struct EpiSwigluT {
    unsigned char* act; const float* bupp; float sc;
    __device__ __forceinline__ void operator()(const f32x4 (&acc)[2][2][4][2], const Unit& u, int wr, int wc, int fr, int fq) const {
        const int pc = wc * 32 + fq * 8, e = u.pb >> 4;
        const float* bp = bupp + e * 4096 + u.pn * 256 + pc;
        f32x4 bg[2], bl[2];
#pragma unroll
        for (int n = 0; n < 2; ++n) { bg[n] = *(const f32x4*)(bp + 4 * n); bl[n] = *(const f32x4*)(bp + HALF + 4 * n); }
#pragma unroll
        for (int ai = 0; ai < 2; ++ai)
#pragma unroll
            for (int m = 0; m < 4; ++m) {
                const int row = u.pm * BM + ai * HALF + wr * 64 + m * 16 + fr;
                float o[8];
#pragma unroll
                for (int n = 0; n < 2; ++n)
#pragma unroll
                    for (int i = 0; i < 4; ++i) {
                        float g = acc[ai][0][m][n][i] * sc + bg[n][i], l = acc[ai][1][m][n][i] * sc + bl[n][i];
                        g = fminf(g, 7.f); l = fminf(fmaxf(l, -7.f), 7.f);
                        o[4 * n + i] = g * sigm_fast(1.702f * g) * (l + 1.f);
                    }
                if constexpr (OUT8) { u32x2 w; w.x = pk4_fp8(o[0], o[1], o[2], o[3]); w.y = pk4_fp8(o[4], o[5], o[6], o[7]);
                    *(u32x2*)(act + (size_t)row * DM + u.pn * HALF + pc) = w; }
                else { u32x4 w; w.x = cvt_pk_bf16(o[0], o[1]); w.y = cvt_pk_bf16(o[2], o[3]); w.z = cvt_pk_bf16(o[4], o[5]); w.w = cvt_pk_bf16(o[6], o[7]);
                    *(u32x4*)((bf16_t*)act + (size_t)row * DM + u.pn * HALF + pc) = w; }
            }
    }
};
constexpr float Y8_SCALE = 16.f;
struct EpiDown {
    unsigned char* y; const float* bdn; const float* roww; float sc;
    __device__ __forceinline__ void operator()(const f32x4 (&acc)[2][2][4][2], const Unit& u, int wr, int wc, int fr, int fq) const {
        const int c0 = u.pn * BM + wc * 32 + fq * 8, e = u.pb >> 3;
        f32x4 bv[2][2];
#pragma unroll
        for (int bj = 0; bj < 2; ++bj)
#pragma unroll
            for (int n = 0; n < 2; ++n) bv[bj][n] = *(const f32x4*)(bdn + e * DM + c0 + bj * HALF + 4 * n);
#pragma unroll
        for (int ai = 0; ai < 2; ++ai)
#pragma unroll
            for (int m = 0; m < 4; ++m) {
                const int row = u.pm * BM + ai * HALF + wr * 64 + m * 16 + fr; const float rw = roww[row] * Y8_SCALE;
#pragma unroll
                for (int bj = 0; bj < 2; ++bj) {
                    const f32x4 v0 = (acc[ai][bj][m][0] * sc + bv[bj][0]) * rw, v1 = (acc[ai][bj][m][1] * sc + bv[bj][1]) * rw;
                    u32x2 w; w.x = pk4_fp8(v0[0], v0[1], v0[2], v0[3]); w.y = pk4_fp8(v1[0], v1[1], v1[2], v1[3]);
                    *(u32x2*)(y + (size_t)row * DM + c0 + bj * HALF) = w;
                }
            }
    }
};
}
#define XB_TMO      128
#define XB_XCNT(j)  (256  + 64 * (j))
#define XB_XSUB(j)  (1280 + 64 * (j))
#define XB_XGEN(j)  (2304 + 64 * (j))
#define XB_TOP      3328
#define XB_TOPGEN   3392
#define XCD_BAR_WORDS 3456
#define XB_SPIN_CAP (1u << 22)

__device__ __forceinline__ unsigned xb_ld(unsigned* p)              { return __hip_atomic_load(p, __ATOMIC_RELAXED, __HIP_MEMORY_SCOPE_AGENT); }
__device__ __forceinline__ unsigned xb_add(unsigned* p, unsigned v) { return __hip_atomic_fetch_add(p, v, __ATOMIC_RELAXED, __HIP_MEMORY_SCOPE_AGENT); }
__device__ __forceinline__ unsigned xb_xcc_id() { return (unsigned)__builtin_amdgcn_s_getreg((3 << 11) | 20) & 0xFu; }
#define XB_SPIN(cond, bar) do { unsigned _sp = 0; while (cond) { __builtin_amdgcn_s_sleep(1); \
    if ((++_sp & 255u) == 0u) { if (xb_ld(&(bar)[XB_TMO])) break; if (_sp > XB_SPIN_CAP) { atomicAdd(&(bar)[XB_TMO], 1u); break; } } } } while (0)

struct XcdBarrier {
    unsigned* bar; unsigned x;
    volatile LAS unsigned* st;
};
__device__ __forceinline__ XcdBarrier xcd_barrier_post(unsigned* bar, volatile LAS unsigned* st) {
    XcdBarrier b; b.bar = bar; b.x = xb_xcc_id(); b.st = st;
    if (threadIdx.x == 0) (void)xb_add(&bar[XB_XCNT(b.x)], 1u);
    return b;
}
__device__ __forceinline__ void xcd_barrier_complete(unsigned* bar, unsigned x, unsigned& nloc, unsigned& nx) {
    const unsigned G = gridDim.x * gridDim.y * gridDim.z;
    unsigned sum, cnt, mine, sp = 0u;
    for (;;) {
        sum = 0u; cnt = 0u; mine = 0u;
#pragma unroll
        for (unsigned j = 0; j < 16; ++j) { const unsigned c = xb_ld(&bar[XB_XCNT(j)]); sum += c; cnt += (c > 0u) ? 1u : 0u; mine = (j == x) ? c : mine; }
        if (sum == G) break;
        __builtin_amdgcn_s_sleep(1);
        if ((++sp & 255u) == 0u) { if (xb_ld(&bar[XB_TMO])) break; if (sp > XB_SPIN_CAP) { atomicAdd(&bar[XB_TMO], 1u); break; } }
    }
    nloc = mine > 0u ? mine : 1u; nx = cnt > 0u ? cnt : 1u;
}
__device__ __forceinline__ void xcd_barrier(const XcdBarrier& b, const bool leader  ) {
    asm volatile("s_waitcnt vmcnt(0)" ::: "memory");
    __syncthreads();
    if (leader) {
        unsigned* bar = b.bar;
        __builtin_amdgcn_s_waitcnt(0);
        unsigned nloc = b.st[0], nx = b.st[1];
        if (nloc == 0u) { xcd_barrier_complete(bar, b.x, nloc, nx); b.st[0] = nloc; b.st[1] = nx; }
        const unsigned old = xb_add(&bar[XB_XSUB(b.x)], 1u);
        const unsigned gen = old / nloc;
        if (old + 1u == (gen + 1u) * nloc) {
            __builtin_amdgcn_fence(__ATOMIC_RELEASE, "agent");
            asm volatile("s_waitcnt vmcnt(0)" ::: "memory");
            const unsigned og = xb_add(&bar[XB_TOP], 1u);
            const unsigned tg = og / nx;
            if (og + 1u == (tg + 1u) * nx) xb_add(&bar[XB_TOPGEN], 1u);
            else XB_SPIN(xb_ld(&bar[XB_TOPGEN]) == tg, bar);
            __builtin_amdgcn_fence(__ATOMIC_ACQUIRE, "agent");
            xb_add(&bar[XB_XGEN(b.x)], 1u);
            asm volatile("s_waitcnt vmcnt(0)" ::: "memory");
        } else {
            XB_SPIN(xb_ld(&bar[XB_XGEN(b.x)]) == gen, bar);
            __builtin_amdgcn_fence(__ATOMIC_ACQUIRE, "agent");
            asm volatile("s_waitcnt vmcnt(0)" ::: "memory");
        }
    }
    __syncthreads();
}
#ifndef PROBE_SUB
#define PROBE_SUB 0
#endif
constexpr int NWAVES = 8;
constexpr int RING_OFF = 0, RING_BYTES = 131072;
constexpr int SCR_WAVE_BYTES = 64 * 65 * 4;
constexpr int LDSCTL_OFF = 139264, MISC_OFF = LDSCTL_OFF + 320;
constexpr int LDS_BYTES = 147456;
static_assert(NWAVES * SCR_WAVE_BYTES <= LDSCTL_OFF && MISC_OFF + 128 <= LDS_BYTES, "LDS map");

struct Frame {
    LAS unsigned char* lds;
    volatile LAS unsigned* MISC;
    unsigned* ctl;
    int tid, lane, wave, vcu, G;
};

template <class ColFn>
__device__ __forceinline__ void transpose_item(const float* W, int ldw, int K, bf16_t* WT, int dst_row0, int k0, ColFn colfn, LAS float* scr, int lane) {
    const int ks = lane >> 4, n4 = lane & 15; const int sc = colfn(n4);
    f32x4 v[16];
#pragma unroll
    for (int i = 0; i < 16; ++i) v[i] = sc >= 0 ? *(const f32x4*)(W + (size_t)(k0 + 4 * i + ks) * ldw + sc) : (f32x4){0.f, 0.f, 0.f, 0.f};
#pragma unroll
    for (int i = 0; i < 16; ++i) {
        *(LAS f32x4*)(scr + (4 * i + ks) * 64 + ((n4 ^ (i >> 1)) << 2)) = v[i];
    }
    asm volatile("s_waitcnt lgkmcnt(0)" ::: "memory");
    const int nsub = lane >> 3, c = lane & 7;
#pragma unroll
    for (int q = 0; q < 8; ++q) {
        const int n = 8 * q + nsub; const LAS float* s = scr + (8 * c) * 64 + (n ^ (c << 2));
        u32x4 o; o.x = cvt_pk_bf16(s[0 * 64], s[1 * 64]); o.y = cvt_pk_bf16(s[2 * 64], s[3 * 64]); o.z = cvt_pk_bf16(s[4 * 64], s[5 * 64]); o.w = cvt_pk_bf16(s[6 * 64], s[7 * 64]);
        *(u32x4*)(WT + (size_t)(dst_row0 + n) * K + k0 + 8 * c) = o;
    }
    asm volatile("s_waitcnt lgkmcnt(0)" ::: "memory");
}

template <class ColFn>
__device__ __forceinline__ void transpose_item8(const float* W, int ldw, int K, unsigned char* WT, int dst_row0, int k0, ColFn colfn, LAS float* scr, int lane, float wscale) {
    const int ks = lane >> 4, n4 = lane & 15; const int sc = colfn(n4);
    f32x4 v[16];
#pragma unroll
    for (int i = 0; i < 16; ++i) v[i] = sc >= 0 ? *(const f32x4*)(W + (size_t)(k0 + 4 * i + ks) * ldw + sc) : (f32x4){0.f, 0.f, 0.f, 0.f};
#pragma unroll
    for (int i = 0; i < 16; ++i) {
        *(LAS f32x4*)(scr + (4 * i + ks) * 64 + ((n4 ^ (i >> 1)) << 2)) = v[i];
    }
    asm volatile("s_waitcnt lgkmcnt(0)" ::: "memory");
    const int nsub = lane >> 3, c = lane & 7;
#pragma unroll
    for (int q = 0; q < 8; ++q) {
        const int n = 8 * q + nsub; const LAS float* s = scr + (8 * c) * 64 + (n ^ (c << 2));
        u32x2 o; o.x = pg8::pk4_fp8(s[0 * 64] * wscale, s[1 * 64] * wscale, s[2 * 64] * wscale, s[3 * 64] * wscale); o.y = pg8::pk4_fp8(s[4 * 64] * wscale, s[5 * 64] * wscale, s[6 * 64] * wscale, s[7 * 64] * wscale);
        *(u32x2*)(WT + (size_t)(dst_row0 + n) * K + k0 + 8 * c) = o;
    }
    asm volatile("s_waitcnt lgkmcnt(0)" ::: "memory");
}
constexpr float W8_SCALE = 64.f;
struct MoeWItem { const float* src; unsigned char* dst; int ldw; };
__device__ __forceinline__ MoeWItem moe_w_decode(const Args& a, int idx, int wv, int lane) {
    unsigned char* ws = a.ws; const int ks = lane >> 4, n4 = lane & 15; MoeWItem it;
    if (idx < 8192) { const int e = idx >> 8, rem = idx & 255, grp = rem & 63, kb = (rem >> 6) * 8 + wv, r0 = grp * 64, pn = r0 >> 8, p0 = r0 & 255;
        const int sc0 = (p0 < 128 ? 128 * pn + p0 : 2048 + 128 * pn + p0 - 128) + 4 * n4;
        it.src = a.in[16] + (size_t)e * DM * 4096 + (size_t)(kb * 64 + ks) * 4096 + sc0; it.ldw = 4096; it.dst = (unsigned char*)(ws + WS_WUP) + (size_t)e * 4096 * DM + (size_t)r0 * DM + kb * 64; }
    else { const int i2 = idx - 8192, e = i2 >> 7, rem = i2 & 127, grp = rem & 31, kb = (rem >> 5) * 8 + wv, r0 = grp * 64;
        it.src = a.in[18] + (size_t)e * DM * DM + (size_t)(kb * 64 + ks) * DM + r0 + 4 * n4; it.ldw = DM; it.dst = (unsigned char*)(ws + WS_WDN) + (size_t)e * DM * DM + (size_t)r0 * DM + kb * 64; }
    return it;
}
__device__ __forceinline__ void moe_w_load(f32x4 (&v)[16], const MoeWItem& it) {
#pragma unroll
    for (int i = 0; i < 16; ++i) v[i] = *(const f32x4*)(it.src + (size_t)(4 * i) * it.ldw);
}
__device__ __forceinline__ void moe_w_to_lds(const f32x4 (&v)[16], LAS float* scr, int lane) {
    const int ks = lane >> 4, n4 = lane & 15;
#pragma unroll
    for (int i = 0; i < 16; ++i) *(LAS f32x4*)(scr + (4 * i + ks) * 64 + ((n4 ^ (i >> 1)) << 2)) = v[i];
    asm volatile("s_waitcnt lgkmcnt(0)" ::: "memory");
}
__device__ __forceinline__ void moe_w_from_lds(const MoeWItem& it, LAS float* scr, int lane) {
    const int nsub = lane >> 3, c = lane & 7;
#pragma unroll
    for (int q = 0; q < 8; ++q) {
        const int n = 8 * q + nsub; const LAS float* s = scr + (8 * c) * 64 + (n ^ (c << 2));
        u32x2 o; o.x = pg8::pk4_fp8(s[0 * 64] * W8_SCALE, s[1 * 64] * W8_SCALE, s[2 * 64] * W8_SCALE, s[3 * 64] * W8_SCALE); o.y = pg8::pk4_fp8(s[4 * 64] * W8_SCALE, s[5 * 64] * W8_SCALE, s[6 * 64] * W8_SCALE, s[7 * 64] * W8_SCALE);
        *(u32x2*)(it.dst + (size_t)n * DM + 8 * c) = o;
    }
    asm volatile("s_waitcnt lgkmcnt(0)" ::: "memory");
}
__device__ __forceinline__ void moe_w_batch(const Args& a, int i0, int i1, LAS float* scr, int wv, int lane) {
    if (i0 >= i1) return;
    f32x4 v[16];
    MoeWItem cur = moe_w_decode(a, i0, wv, lane);
    moe_w_load(v, cur);
#pragma unroll 1
    for (int i = i0; i < i1; ++i) {
        moe_w_to_lds(v, scr, lane);
        MoeWItem nxt = cur;
        if (i + 1 < i1) { nxt = moe_w_decode(a, i + 1, wv, lane); moe_w_load(v, nxt); }
        moe_w_from_lds(cur, scr, lane);
        cur = nxt;
    }
}
constexpr int MOE_W_ITEMS = 8192 + 4096, MOE_W_BATCH = 8;
__device__ __forceinline__ void p0_prologue(Frame& F, const Args& a) {
    unsigned char* ws = a.ws;
    LAS float* scr = (LAS float*)(F.lds + F.wave * SCR_WAVE_BYTES);
    const int gw = F.vcu * NWAVES + F.wave, NGW = F.G * NWAVES, gt = gw * 64 + F.lane, NGT = NGW * 64;
    { float* rc = (float*)(ws + WS_ROPE); float* rs = rc + 4096 * 64;
      for (int i = gt; i < 4096 * 64; i += NGT) { const int t = i >> 6, j = i & 63; const float inv = powf(10000.f, -(float)(2 * j) / 128.f); const float ang = (float)t * inv; float sn, cs; sincosf(ang, &sn, &cs); rc[i] = cs; rs[i] = sn; }
      int* rowtok = (int*)(ws + WS_ROUTE + 4 * 512 * 1024); float* roww = (float*)(ws + WS_ROUTE + 4 * 512 * 1024 + 544 * 1024);
      for (int i = gt; i < MOE_ROWS; i += NGT) { rowtok[i] = T_; roww[i] = 0.f; }
      if (gt < 128) *(u32x4*)(ws + WS_HB + (size_t)T_ * DM + gt * 16) = (u32x4){0u, 0u, 0u, 0u};
      float* binp = (float*)(ws + WS_BINP); const float* b_in = a.in[2];
      for (int i = gt; i < LDP; i += NGT) { const int pn = i >> 8, wc = wcol_of(pn * 256 + inproj_phys2log(pn, i & 255)); binp[i] = wc >= 0 ? b_in[wc] : 0.f; }
      { const float* wr_ = a.in[14]; bf16_t* wrh = (bf16_t*)(ws + WS_WRT); bf16_t* wrl = wrh + 32 * 2048;
        for (int i = gt; i < 32 * 2048; i += NGT) { const int e = i >> 11, k = i & 2047; const float w = wr_[k * 32 + e]; const unsigned hb_ = cvt_pk_bf16(w, 0.f) & 0xffffu;
            wrh[i] = (bf16_t)hb_; wrl[i] = (bf16_t)(cvt_pk_bf16(w - __uint_as_float(hb_ << 16), 0.f) & 0xffffu); } }
      float* bupp = (float*)(ws + WS_BUPP); const float* b_up = a.in[17];
      for (int i = gt; i < NEXP * 4096; i += NGT) { const int e = i >> 12, n = i & 4095, pn = n >> 8, p = n & 255; bupp[i] = b_up[e * 4096 + (p < 128 ? 128 * pn + p : 2048 + 128 * pn + p - 128)]; }
    }
    if (gw < 128) { const int which = gw >> 6, chunk = (gw >> 2) & 15, n = (gw & 3) * 64 + F.lane; const float* pos = a.in[3 + which] + chunk * 256; const float* w1 = a.in[which ? 7 : 5] + (size_t)chunk * 256 * 256; float acc = 0.f;
#pragma unroll 16
        for (int k = 0; k < 256; ++k) acc += pos[k] * w1[(size_t)k * 256 + n];
        ((float*)(ws + WS_POSB))[(which * 16 + chunk) * 256 + n] = acc; }
    { const float* x = a.in[0]; bf16_t* xb = (bf16_t*)(ws + WS_XB); const float* w_in = a.in[1]; const float* b_in = a.in[2];
      constexpr int GLP = 4112;
      for (int idx = F.tid; idx < 2048 * 8; idx += NWAVES * 64) { const int k = idx >> 3, q = idx & 7;
          f32x4 w = {0.f, 0.f, 0.f, 0.f}; if (q < 6) w = *(const f32x4*)(w_in + (size_t)k * IN_W + 2560 + 4 * q);
#pragma unroll
          for (int i = 0; i < 4; ++i) *(LAS unsigned short*)(F.lds + (4 * q + i) * GLP + k * 2) = (unsigned short)(cvt_pk_bf16(w[i], 0.f) & 0xffffu); }
      __syncthreads();
      const int i = F.lane & 15, kq = F.lane >> 4;
      bf16_t* gl = (bf16_t*)(ws + WS_PROJ + PJ_GL);
      const float bias0 = b_in[2560 + i], bias1 = i < 8 ? b_in[2560 + 16 + i] : 0.f;
      for (int grp = gw; grp < T_ / 16; grp += NGW) {
          const int r0 = grp * 16;
          const float* xr = x + (size_t)(r0 + i) * DM + 4 * kq; bf16_t* xo = xb + (size_t)(r0 + i) * DM + 4 * kq;
          const LAS unsigned char* bp = F.lds + i * GLP + kq * 8;
          f32x4 acc0 = {0.f, 0.f, 0.f, 0.f}, acc1 = {0.f, 0.f, 0.f, 0.f};
#pragma unroll 1
          for (int sb = 0; sb < 64; sb += 8) {
              f32x4 xa[8], xc[8];
#pragma unroll
              for (int u = 0; u < 8; ++u) { xa[u] = *(const f32x4*)(xr + 32 * (sb + u)); xc[u] = *(const f32x4*)(xr + 32 * (sb + u) + 16); }
#pragma unroll
              for (int u = 0; u < 8; ++u) { const int s2 = sb + u;
                  u32x4 pk; pk.x = cvt_pk_bf16(xa[u][0], xa[u][1]); pk.y = cvt_pk_bf16(xa[u][2], xa[u][3]); pk.z = cvt_pk_bf16(xc[u][0], xc[u][1]); pk.w = cvt_pk_bf16(xc[u][2], xc[u][3]);
                  { u32x2 lo_; lo_.x = pk.x; lo_.y = pk.y; u32x2 hi_; hi_.x = pk.z; hi_.y = pk.w; *(u32x2*)(xo + 32 * s2) = lo_; *(u32x2*)(xo + 32 * s2 + 16) = hi_; }
                  u32x4 b0, b1; { const u32x2 p0 = *(const LAS u32x2*)(bp + s2 * 64), p1 = *(const LAS u32x2*)(bp + s2 * 64 + 32), q0 = *(const LAS u32x2*)(bp + 16 * GLP + s2 * 64), q1 = *(const LAS u32x2*)(bp + 16 * GLP + s2 * 64 + 32); b0.x = p0.x; b0.y = p0.y; b0.z = p1.x; b0.w = p1.y; b1.x = q0.x; b1.y = q0.y; b1.z = q1.x; b1.w = q1.y; }
                  acc0 = __builtin_amdgcn_mfma_f32_16x16x32_bf16(__builtin_bit_cast(bf16x8, pk), __builtin_bit_cast(bf16x8, b0), acc0, 0, 0, 0);
                  acc1 = __builtin_amdgcn_mfma_f32_16x16x32_bf16(__builtin_bit_cast(bf16x8, pk), __builtin_bit_cast(bf16x8, b1), acc1, 0, 0, 0); }
          }
#pragma unroll
          for (int r = 0; r < 4; ++r) { const size_t tok = (size_t)(r0 + 4 * kq + r);
              gl[tok * 32 + i] = (bf16_t)(cvt_pk_bf16(sigm_fast(acc0[r] + bias0), 0.f) & 0xffffu);
              gl[tok * 32 + 16 + i] = (bf16_t)(cvt_pk_bf16(sigm_fast(acc1[r] + bias1), 0.f) & 0xffffu); }
      }
      __syncthreads();
    }
    const int wg = F.vcu, NWG = F.G, wv = F.wave;
#define TR_LOOP8(nmat, ngrp, nk, W_OF, LDW, KK, WT_OF, ROW0_OF, COLFN) \
    for (int wi = wg; wi < (nmat) * (ngrp) * (((nk) + 7) / 8); wi += NWG) { \
        const int per = (ngrp) * (((nk) + 7) / 8), e = wi / per, rem = wi - e * per, grp = rem % (ngrp), kb = (rem / (ngrp)) * 8 + wv; \
        if (kb < (nk)) { const int r0 = (ROW0_OF); transpose_item8((W_OF), (LDW), (KK), (WT_OF), r0, kb * 64, COLFN, scr, F.lane, W8_SCALE); } }
#define TR_LOOP(OFF, nmat, ngrp, nk, W_OF, LDW, KK, WT_OF, ROW0_OF, COLFN) \
    for (int wi = (wg + NWG - ((OFF) % NWG)) % NWG; wi < (nmat) * (ngrp) * (((nk) + 7) / 8); wi += NWG) {        \
        const int per = (ngrp) * (((nk) + 7) / 8), e = wi / per, rem = wi - e * per, grp = rem % (ngrp), kb = (rem / (ngrp)) * 8 + wv; \
        if (kb < (nk)) { const int r0 = (ROW0_OF); transpose_item((W_OF), (LDW), (KK), (WT_OF), r0, kb * 64, COLFN, scr, F.lane); } }
    TR_LOOP(0, 1, 176, 32, a.in[1], IN_W, DM, (bf16_t*)(ws + WS_WIN), grp * 64, ([&](int n4) { const int pn = r0 >> 8; return wcol_of(pn * 256 + inproj_phys2log(pn, (r0 & 255) + 4 * n4)); }))
    TR_LOOP(704, 1, 32, 16, a.in[9], DM, 1024, (bf16_t*)(ws + WS_WBA), grp * 64, ([&](int n4) { return r0 + 4 * n4; }))
    TR_LOOP(768, 1, 32, 8, a.in[10], DM, 512, (bf16_t*)(ws + WS_WBD), grp * 64, ([&](int n4) { return r0 + 4 * n4; }))
    TR_LOOP(800, 1, 32, 32, a.in[11], DM, DM, (bf16_t*)(ws + WS_WOUT), grp * 64, ([&](int n4) { return r0 + 4 * n4; }))
    TR_LOOP(928, 2, 4, 64, a.in[e ? 7 : 5], 256, 4096, (bf16_t*)(ws + WS_CW1) + (size_t)e * 256 * 4096, grp * 64, ([&](int n4) { return r0 + 4 * n4; }))
    TR_LOOP(992, 2, 2, 4, a.in[e ? 8 : 6], 128, 256, (bf16_t*)(ws + WS_CW2) + (size_t)e * 128 * 256, grp * 64, ([&](int n4) { return r0 + 4 * n4; }))
#undef TR_LOOP
#undef TR_LOOP8
}
__device__ __forceinline__ void p_ln1_router(Frame& F, const Args& a) {
    unsigned char* ws = a.ws;
    const float* g = a.in[12]; const float* bb = a.in[13]; const float* wr = a.in[14]; const float* br = a.in[15];
    unsigned* ctl = F.ctl;
    int* topi = (int*)(ws + WS_ROUTE); float* topw = (float*)(ws + WS_ROUTE + 512 * 1024); int* pos = (int*)(ws + WS_ROUTE + 2 * 512 * 1024);
    const int gw = F.vcu * NWAVES + F.wave, NGW = F.G * NWAVES, lane = F.lane;
    LAS float* lt = (LAS float*)(F.lds) + F.wave * (16 * 33);
    for (int grp = gw; grp < T_ / 16; grp += NGW) {
        const int tok0 = grp * 16;
        const float* x = a.in[0]; const bf16_t* ub = (const bf16_t*)(ws + WS_Z);
        f32x4 xn[8]; u32x4 un[4];
#pragma unroll
        for (int j = 0; j < 4; ++j) { const size_t o = (size_t)tok0 * DM + (lane + 64 * j) * 8; xn[2 * j] = *(const f32x4*)(x + o); xn[2 * j + 1] = *(const f32x4*)(x + o + 4); un[j] = *(const u32x4*)(ub + o); }
#pragma unroll 1
        for (int ti = 0; ti < 16; ++ti) {
            const int tok = tok0 + ti;
            bf16_t* hh = (bf16_t*)(ws + WS_H) + (size_t)tok * DM; bf16_t* hl = hh + (size_t)T_ * DM; unsigned char* hb = (unsigned char*)(ws + WS_HB) + (size_t)tok * DM;
            float v[32]; float s = 0.f;
#pragma unroll
            for (int j = 0; j < 4; ++j)
#pragma unroll
                for (int i = 0; i < 8; ++i) { const unsigned w = un[j][i >> 1]; const float uu = __uint_as_float((i & 1) ? (w & 0xffff0000u) : (w << 16)); const float t = DN_ALPHA * xn[2 * j + (i >> 2)][i & 3] + uu; v[8 * j + i] = t; s += t; }
            { const size_t o1 = (size_t)(tok + (ti < 15 ? 1 : 0)) * DM;
#pragma unroll
              for (int j = 0; j < 4; ++j) { const size_t o = o1 + (lane + 64 * j) * 8; xn[2 * j] = *(const f32x4*)(x + o); xn[2 * j + 1] = *(const f32x4*)(x + o + 4); un[j] = *(const u32x4*)(ub + o); } }
            const float mean = wave_sum(s) * (1.f / DM); float q = 0.f;
#pragma unroll
            for (int i = 0; i < 32; ++i) { v[i] -= mean; q += v[i] * v[i]; }
            const float rstd = rsqrtf(wave_sum(q) * (1.f / DM) + LN_EPS);
#pragma unroll
            for (int j = 0; j < 4; ++j) {
                const int k0 = (lane + 64 * j) * 8;
                float hv[8];
#pragma unroll
                for (int hlf = 0; hlf < 2; ++hlf) { const f32x4 gv = *(const f32x4*)(g + k0 + 4 * hlf), bv = *(const f32x4*)(bb + k0 + 4 * hlf);
#pragma unroll
                    for (int i = 0; i < 4; ++i) hv[4 * hlf + i] = v[8 * j + 4 * hlf + i] * rstd * gv[i] + bv[i]; }
                { u32x4 wh, wl;
#pragma unroll
                  for (int i = 0; i < 4; ++i) { const unsigned ph = cvt_pk_bf16(hv[2 * i], hv[2 * i + 1]); wh[i] = ph;
                      wl[i] = cvt_pk_bf16(hv[2 * i] - __uint_as_float(ph << 16), hv[2 * i + 1] - __uint_as_float(ph & 0xffff0000u)); }
                  *(u32x4*)(hh + k0) = wh; *(u32x4*)(hl + k0) = wl; }
                u32x2 w8; w8.x = pg8::pk4_fp8(hv[0], hv[1], hv[2], hv[3]); w8.y = pg8::pk4_fp8(hv[4], hv[5], hv[6], hv[7]);
                *(u32x2*)(hb + k0) = w8;
            }
        }
        asm volatile("s_waitcnt vmcnt(0)" ::: "memory");
        { const int i = lane & 15, kq = lane >> 4;
          const bf16_t* ah = (const bf16_t*)(ws + WS_H) + (size_t)(tok0 + i) * DM + kq * 8; const bf16_t* al = ah + (size_t)T_ * DM;
          const bf16_t* bh0 = (const bf16_t*)(ws + WS_WRT) + (size_t)i * 2048 + kq * 8; const bf16_t* bl0 = bh0 + 32 * 2048;
          f32x4 acc0 = {0.f, 0.f, 0.f, 0.f}, acc1 = {0.f, 0.f, 0.f, 0.f};
#pragma unroll 4
          for (int s2 = 0; s2 < 64; ++s2) {
              const bf16x8 xh = *(const bf16x8*)(ah + 32 * s2), xl = *(const bf16x8*)(al + 32 * s2);
              const bf16x8 wh0 = *(const bf16x8*)(bh0 + 32 * s2), wl0 = *(const bf16x8*)(bl0 + 32 * s2), wh1 = *(const bf16x8*)(bh0 + 16 * 2048 + 32 * s2), wl1 = *(const bf16x8*)(bl0 + 16 * 2048 + 32 * s2);
              acc0 = __builtin_amdgcn_mfma_f32_16x16x32_bf16(xh, wl0, acc0, 0, 0, 0); acc0 = __builtin_amdgcn_mfma_f32_16x16x32_bf16(xl, wh0, acc0, 0, 0, 0); acc0 = __builtin_amdgcn_mfma_f32_16x16x32_bf16(xh, wh0, acc0, 0, 0, 0);
              acc1 = __builtin_amdgcn_mfma_f32_16x16x32_bf16(xh, wl1, acc1, 0, 0, 0); acc1 = __builtin_amdgcn_mfma_f32_16x16x32_bf16(xl, wh1, acc1, 0, 0, 0); acc1 = __builtin_amdgcn_mfma_f32_16x16x32_bf16(xh, wh1, acc1, 0, 0, 0);
          }
#pragma unroll
          for (int r = 0; r < 4; ++r) { lt[(4 * kq + r) * 33 + i] = acc0[r]; lt[(4 * kq + r) * 33 + 16 + i] = acc1[r]; }
        }
        asm volatile("s_waitcnt lgkmcnt(0)" ::: "memory");
        if (lane < 16) {
            const int tok = tok0 + lane;
            float lg[32];
#pragma unroll
            for (int e = 0; e < 32; ++e) lg[e] = lt[lane * 33 + e] + br[e];
            int idx[4]; float val[4];
#pragma unroll
            for (int k = 0; k < 4; ++k) { float best = -INFINITY; int bi = 0;
#pragma unroll
                for (int e = 0; e < 32; ++e) { bool taken = false;
#pragma unroll
                    for (int kk = 0; kk < k; ++kk) taken |= (idx[kk] == e);
                    if (!taken && lg[e] > best) { best = lg[e]; bi = e; } }
                idx[k] = bi; val[k] = best; }
            const float e1 = expf(val[1] - val[0]), e2 = expf(val[2] - val[0]), e3 = expf(val[3] - val[0]), den = 1.f + e1 + e2 + e3;
            const float w4[4] = {1.f / den, e1 / den, e2 / den, e3 / den};
#pragma unroll
            for (int k = 0; k < 4; ++k) { const int e = idx[k]; topi[tok * 4 + k] = e; topw[tok * 4 + k] = w4[k]; pos[tok * 4 + k] = (int)atomicAdd(&ctl[CW_CNT + e], 1u); }
        }
        asm volatile("s_waitcnt lgkmcnt(0)" ::: "memory");
    }
}
__device__ __forceinline__ void p_scatter(Frame& F, const Args& a) {
    unsigned char* ws = a.ws; unsigned* ctl = F.ctl;
    LAS unsigned* pst = (LAS unsigned*)(F.lds);
    if (F.tid == 0) { unsigned acc = 0; for (int e = 0; e < 32; ++e) { pst[e] = acc; acc += ((ctl[CW_CNT + e] + 255u) >> 8) << 8; } pst[32] = acc; }
    __syncthreads();
    if (blockIdx.x == 0) {
        if (F.tid < 32) { const unsigned s0 = pst[F.tid] >> 8, s1 = pst[F.tid + 1] >> 8; for (unsigned t = s0; t < s1; ++t) ctl[CW_TILEEXP + t] = (unsigned)F.tid; }
        if (F.tid == 0) ctl[CW_NTILES] = pst[32] >> 8;
    }
    const int* topi = (const int*)(ws + WS_ROUTE); const float* topw = (const float*)(ws + WS_ROUTE + 512 * 1024); const int* pos = (const int*)(ws + WS_ROUTE + 2 * 512 * 1024);
    int* dest = (int*)(ws + WS_ROUTE + 3 * 512 * 1024);
    int* rowtok = (int*)(ws + WS_ROUTE + 4 * 512 * 1024); float* roww = (float*)(ws + WS_ROUTE + 4 * 512 * 1024 + 544 * 1024);
    for (int i = blockIdx.x * (NWAVES * 64) + F.tid; i < T_ * 4; i += F.G * NWAVES * 64) { const int d = (int)pst[topi[i]] + pos[i]; dest[i] = d; rowtok[d] = i >> 2; roww[d] = topw[i]; }
    __syncthreads();
}
__device__ __forceinline__ void p_final(Frame& F, const Args& a) {
    unsigned char* ws = a.ws;
    const unsigned char* y = (const unsigned char*)(ws + WS_Y);
    typedef int i32x4 __attribute__((ext_vector_type(4)));
    const i32x4* dest4 = (const i32x4*)(ws + WS_ROUTE + 3 * 512 * 1024);
    const float* g = a.in[20]; const float* bb = a.in[21];
    const int gw = F.vcu * NWAVES + F.wave, NGW = F.G * NWAVES, lane = F.lane;
    LAS unsigned char* buf = F.lds + F.wave * 16384;
#define FIN_DMA(tok_, dk_) do { const unsigned char* hs_ = (const unsigned char*)(ws + WS_H) + (size_t)(tok_) * (DM * 2) + lane * 16;        \
        _Pragma("unroll") for (int q = 0; q < 4; ++q) __builtin_amdgcn_global_load_lds((const unsigned*)(hs_ + q * 1024), (LAS unsigned*)(buf + q * 1024), 16, 0, 0); \
        _Pragma("unroll") for (int k = 0; k < 4; ++k) { const unsigned char* ys_ = y + (size_t)dk_[k] * DM + lane * 16; \
            _Pragma("unroll") for (int q = 0; q < 2; ++q) __builtin_amdgcn_global_load_lds((const unsigned*)(ys_ + q * 1024), (LAS unsigned*)(buf + 8192 + k * 2048 + q * 1024), 16, 0, 0); } } while (0)
    int tok = gw; if (tok >= T_) return;
    f32x4 GV[8], BV[8];
#pragma unroll
    for (int j = 0; j < 4; ++j)
#pragma unroll
        for (int hlf = 0; hlf < 2; ++hlf) { GV[2 * j + hlf] = *(const f32x4*)(g + (lane + 64 * j) * 8 + 4 * hlf); BV[2 * j + hlf] = *(const f32x4*)(bb + (lane + 64 * j) * 8 + 4 * hlf); }
#pragma unroll
    for (int j = 0; j < 8; ++j) asm volatile("" : "+v"(GV[j]), "+v"(BV[j]));
    i32x4 d1 = dest4[tok + NGW < T_ ? tok + NGW : tok];
    { const i32x4 d0 = dest4[tok]; FIN_DMA(tok, d0); }
    asm volatile("s_waitcnt vmcnt(0)" ::: "memory");
#pragma unroll 1
    for (;;) {
        const int tok1 = tok + NGW, tok2 = tok + 2 * NGW;
        u32x4 H[4]; u32x2 Y[16];
#pragma unroll
        for (int j = 0; j < 4; ++j) { H[j] = *(const LAS u32x4*)(buf + (lane + 64 * j) * 16);
#pragma unroll
            for (int k = 0; k < 4; ++k) Y[4 * j + k] = *(const LAS u32x2*)(buf + 8192 + k * 2048 + (lane + 64 * j) * 8); }
        asm volatile("s_waitcnt lgkmcnt(0)" ::: "memory");
        const i32x4 d2 = dest4[tok2 < T_ ? tok2 : tok];
        if (tok1 < T_) FIN_DMA(tok1, d1);
        float v[32]; float s = 0.f;
#pragma unroll
        for (int j = 0; j < 4; ++j) { float f[8] = {0.f, 0.f, 0.f, 0.f, 0.f, 0.f, 0.f, 0.f};
#pragma unroll
            for (int k = 0; k < 4; ++k)
#pragma unroll
                for (int i = 0; i < 2; ++i) { const auto lo = __builtin_amdgcn_cvt_pk_f32_fp8((int)Y[4 * j + k][i], false), hi2 = __builtin_amdgcn_cvt_pk_f32_fp8((int)Y[4 * j + k][i], true);
                    f[4 * i] += lo[0]; f[4 * i + 1] += lo[1]; f[4 * i + 2] += hi2[0]; f[4 * i + 3] += hi2[1]; }
#pragma unroll
            for (int i = 0; i < 8; ++i) { const unsigned hw_ = H[j][i >> 1]; const float hv_ = __uint_as_float((i & 1) ? (hw_ & 0xffff0000u) : (hw_ << 16));
                const float t = DN_ALPHA * hv_ + f[i] * (1.f / pg8::Y8_SCALE); v[8 * j + i] = t; s += t; } }
        const float mean = wave_sum(s) * (1.f / DM); float q2 = 0.f;
#pragma unroll
        for (int i = 0; i < 32; ++i) { v[i] -= mean; q2 += v[i] * v[i]; }
        const float rstd = rsqrtf(wave_sum(q2) * (1.f / DM) + LN_EPS);
#pragma unroll
        for (int j = 0; j < 4; ++j) { const int c = (lane + 64 * j) * 8;
#pragma unroll
            for (int hlf = 0; hlf < 2; ++hlf) { const f32x4 gv = GV[2 * j + hlf], bv = BV[2 * j + hlf]; f32x4 o;
#pragma unroll
                for (int i = 0; i < 4; ++i) o[i] = v[8 * j + 4 * hlf + i] * rstd * gv[i] + bv[i];
                *(f32x4*)(a.out + (size_t)tok * DM + c + 4 * hlf) = o; } }
        if (tok1 >= T_) break;
        asm volatile("s_waitcnt vmcnt(8)" ::: "memory");
        tok = tok1; d1 = d2;
    }
    asm volatile("s_waitcnt vmcnt(0)" ::: "memory");
#undef FIN_DMA
}
namespace fa {
typedef short s16x4 __attribute__((ext_vector_type(4)));
constexpr int SHM_V = 16384, SHM_K = 16384;
constexpr int L_V = 0, L_K = 2 * SHM_V, L_WS = L_K + 2 * SHM_K, L_IMP = L_WS + 2048, L_SELM = L_IMP + 65536, L_MISC = L_SELM + 512, L_END = L_MISC + 64;
static_assert(L_END <= LDSCTL_OFF, "attention LDS map");
constexpr int kb_off(int b) { return b < 2 ? L_K + b * SHM_K : L_IMP; }
constexpr int vb_off(int b) { return b < 2 ? L_V + b * SHM_V : L_IMP + SHM_K; }
constexpr float SCALE = ATT_SCALE, C2 = 1.4426950408889634f * ATT_SCALE, THR = 8.f;
#define KSWZ(row, colB) ((row) * 256 + ((colB) ^ (((row) & 7) << 4)))
#define SBAR() __builtin_amdgcn_sched_barrier(0)
__device__ __forceinline__ int v_st(int k, int c) { const int kk = (k & ~0xC) | ((k & 4) << 1) | ((k & 8) >> 1); return ((kk >> 3) * 4 + (c >> 5)) * 512 + ((kk & 7) * 32 + (c & 31)) * 2; }
__device__ __forceinline__ int v_rd_base(int lane) { return ((lane & 3) << 3) | (((lane >> 2) & 3) << 6) | (((lane >> 4) & 1) << 5) | (((lane >> 5) & 1) << 8); }
constexpr int v_rd_off(int d0, int ks, int half) { return d0 * 512 + ks * 4096 + half * 2048; }
__device__ __forceinline__ int crow(int r, int hi) { return (r & 3) + 8 * (r >> 2) + 4 * hi; }
__device__ __forceinline__ unsigned cvtpk(float lo, float hi) { unsigned r; asm volatile("v_cvt_pk_bf16_f32 %0, %1, %2" : "=v"(r) : "v"(lo), "v"(hi)); return r; }

__device__ __forceinline__ void mask_tile(f32x16& p0, f32x16& p1, int dq, unsigned W) {
    const float NEG = -__builtin_inff();
#pragma unroll
    for (int r = 0; r < 16; ++r) {
        const int c = (r & 3) + 8 * (r >> 2);
        if ((unsigned)(dq - c) >= W) p0[r] = NEG;
        if ((unsigned)(dq - c - 32) >= W) p1[r] = NEG;
    }
}
__device__ __forceinline__ void partialSM(f32x16& p0, f32x16& p1, float& m_reg, float& mn, float& alpha) {
    float pmax = p0[0];
#pragma unroll
    for (int r = 1; r < 16; ++r) pmax = fmaxf(pmax, p0[r]);
#pragma unroll
    for (int r = 0; r < 16; ++r) pmax = fmaxf(pmax, p1[r]);
    { auto rr = __builtin_amdgcn_permlane32_swap(__float_as_uint(pmax), __float_as_uint(pmax), false, false);
      pmax = fmaxf(__uint_as_float(rr[0]), __uint_as_float(rr[1])); }
    if (__builtin_expect(__all((pmax - m_reg) * SCALE <= THR), 1)) { mn = m_reg; alpha = 1.f; }
    else { mn = fmaxf(m_reg, pmax); alpha = __builtin_amdgcn_exp2f((m_reg - mn) * C2); m_reg = mn; }
    const float mnL = -mn * C2;
#pragma unroll
    for (int r = 0; r < 16; ++r) p0[r] = fmaf(p0[r], C2, mnL);
#pragma unroll
    for (int r = 0; r < 16; ++r) p1[r] = fmaf(p1[r], C2, mnL);
#pragma unroll
    for (int r = 0; r < 16; ++r) p0[r] = __builtin_amdgcn_exp2f(p0[r]);
}
__device__ __forceinline__ void finishSM(f32x16& p0, f32x16& p1, float alpha, float& l_reg, bf16x8& pa0, bf16x8& pa1, bf16x8& pa2, bf16x8& pa3) {
#pragma unroll
    for (int r = 0; r < 16; ++r) p1[r] = __builtin_amdgcn_exp2f(p1[r]);
    float ps = 0;
#pragma unroll
    for (int r = 0; r < 16; ++r) ps += p0[r];
#pragma unroll
    for (int r = 0; r < 16; ++r) ps += p1[r];
    { auto rr = __builtin_amdgcn_permlane32_swap(__float_as_uint(ps), __float_as_uint(ps), false, false);
      ps = __uint_as_float(rr[0]) + __uint_as_float(rr[1]); }
    l_reg = l_reg * alpha + ps;
#define PK4(P, B_, OUT) do { unsigned a0 = cvtpk(P[B_+0], P[B_+1]), a1 = cvtpk(P[B_+2], P[B_+3]);                          \
        unsigned b0 = cvtpk(P[B_+4], P[B_+5]), b1 = cvtpk(P[B_+6], P[B_+7]);                                             \
        auto r0 = __builtin_amdgcn_permlane32_swap(a0, b0, false, false); auto r1 = __builtin_amdgcn_permlane32_swap(a1, b1, false, false); \
        u32x4 w = {r0[0], r1[0], r0[1], r1[1]}; OUT = *reinterpret_cast<bf16x8*>(&w); } while (0)
    PK4(p0, 0, pa0); PK4(p0, 8, pa1); PK4(p1, 0, pa2); PK4(p1, 8, pa3);
#undef PK4
}
template <int KB>
__device__ __forceinline__ void qkt(f32x16& p0, f32x16& p1, const char* K_lds, int r32, int hi, const bf16x8* qr, const float init = 0.f) {
#pragma unroll
    for (int r = 0; r < 16; ++r) { p0[r] = init; p1[r] = init; }
    const char* kb[4];
#pragma unroll
    for (int dd = 0; dd < 4; ++dd) kb[dd] = K_lds + kb_off(KB) + KSWZ(r32, (dd * 16 + hi * 8) * 2);
#pragma unroll
    for (int d0 = 0; d0 < 8; ++d0) { const char* a = kb[d0 & 3] + (d0 >> 2) * 128;
        bf16x8 b0 = *reinterpret_cast<const bf16x8*>(a);
        bf16x8 b1 = *reinterpret_cast<const bf16x8*>(a + 32 * 256);
        p0 = __builtin_amdgcn_mfma_f32_32x32x16_bf16(b0, qr[d0], p0, 0, 0, 0);
        p1 = __builtin_amdgcn_mfma_f32_32x32x16_bf16(b1, qr[d0], p1, 0, 0, 0);
        if (d0 == 3) SBAR(); }
}
template <int VB>
__device__ __forceinline__ void pv_tile(f32x16* o, int vb0_, int vb2_, bf16x8 pa0, bf16x8 pa1, bf16x8 pa2, bf16x8 pa3) {
    const int vb0 = VB == 2 ? vb2_ : vb0_;
#define TRRD(dst, off) asm volatile("ds_read_b64_tr_b16 %0, %1 offset:%2" : "=&v"(dst) : "v"(vb0), "i"(off) : "memory")
#define PV_D0(d0) do { s16x4 l0, l1, l2, l3, h0, h1, h2, h3; constexpr int b_ = (VB < 2 ? VB * SHM_V : 0) + v_rd_off(d0, 0, 0); \
        TRRD(l0, b_); TRRD(h0, b_ + 2048); TRRD(l1, b_ + 4096); TRRD(h1, b_ + 6144); TRRD(l2, b_ + 8192); TRRD(h2, b_ + 10240); TRRD(l3, b_ + 12288); TRRD(h3, b_ + 14336); \
        asm volatile("s_waitcnt lgkmcnt(0)" ::: "memory"); SBAR(); \
        o[d0] = __builtin_amdgcn_mfma_f32_32x32x16_bf16(pa0, (bf16x8){l0[0], l0[1], l0[2], l0[3], h0[0], h0[1], h0[2], h0[3]}, o[d0], 0, 0, 0);   \
        o[d0] = __builtin_amdgcn_mfma_f32_32x32x16_bf16(pa1, (bf16x8){l1[0], l1[1], l1[2], l1[3], h1[0], h1[1], h1[2], h1[3]}, o[d0], 0, 0, 0);   \
        o[d0] = __builtin_amdgcn_mfma_f32_32x32x16_bf16(pa2, (bf16x8){l2[0], l2[1], l2[2], l2[3], h2[0], h2[1], h2[2], h2[3]}, o[d0], 0, 0, 0);   \
        o[d0] = __builtin_amdgcn_mfma_f32_32x32x16_bf16(pa3, (bf16x8){l3[0], l3[1], l3[2], l3[3], h3[0], h3[1], h3[2], h3[3]}, o[d0], 0, 0, 0); } while (0)
    PV_D0(0); PV_D0(1); PV_D0(2); PV_D0(3);
#undef PV_D0
#undef TRRD
}

struct KVSrc { const bf16_t* k; const bf16_t* v; int ld; int tstride; int toff; };
struct DmaOff { unsigned k[2], v[2]; };
__device__ __forceinline__ void dma_offsets(DmaOff& d, const KVSrc& s, int wid, int lane) {
    const unsigned rs = (unsigned)(s.tstride * s.ld * 2);
#pragma unroll
    for (int i = 0; i < 2; ++i) {
        const int ci = 2 * wid + i, row = 4 * ci + (lane >> 4), colB = ((lane & 15) * 16) ^ ((row & 7) << 4);
        d.k[i] = (unsigned)row * rs + (unsigned)colB;
        const int kk = (ci >> 1) * 8 + ((lane & 31) >> 2), k = (kk & ~0xC) | ((kk & 4) << 1) | ((kk & 8) >> 1), c = (2 * (ci & 1) + (lane >> 5)) * 32 + (lane & 3) * 8;
        d.v[i] = (unsigned)k * rs + (unsigned)c * 2u;
    }
}
template <int BF> __device__ __forceinline__ void dma_issue(const DmaOff& d, const KVSrc& s, int kb, LAS unsigned char* ldsl, int wid) {
    const size_t tb = (size_t)(kb * s.tstride + s.toff) * s.ld * 2;
    const char* kt = (const char*)s.k + tb; const char* vt = (const char*)s.v + tb;
#pragma unroll
    for (int i = 0; i < 2; ++i) {
        __builtin_amdgcn_global_load_lds((const unsigned*)(kt + d.k[i]), (LAS unsigned*)(ldsl + kb_off(BF) + (2 * wid + i) * 1024), 16, 0, 0);
        __builtin_amdgcn_global_load_lds((const unsigned*)(vt + d.v[i]), (LAS unsigned*)(ldsl + vb_off(BF) + (2 * wid + i) * 1024), 16, 0, 0);
    }
}

enum { MODE_BAND = 0, MODE_SEL = 1, MODE_STATS = 2, MODE_IMP = 3 };
template <int MODE>
__device__ __forceinline__ void branch_prefetch(char* lds, const KVSrc& src, int j_lo, int j_hi, unsigned long long tmask, const int wid) {
    const int lane = tid_of(wid) & 63;
    LAS unsigned char* ldsl = (LAS unsigned char*)(unsigned)(uintptr_t)lds;
    DmaOff dof; dma_offsets(dof, src, wid, lane);
    auto next_tile = [&](int j) -> int { if (MODE == MODE_SEL) { while (j < j_hi && !((tmask >> j) & 1ull)) ++j; } return j; };
    const int j = next_tile(j_lo);
    if (j >= j_hi) return;
    dma_issue<0>(dof, src, j * 64, ldsl, wid);
    if constexpr (MODE == MODE_BAND || MODE == MODE_SEL) { const int jnx = next_tile(j + 1); if (jnx < j_hi) dma_issue<1>(dof, src, jnx * 64, ldsl, wid); }
}
template <int MODE, bool PREF = false>
__device__ __forceinline__ void run_branch(char* lds, const bf16x8* qr, const KVSrc& src, int j_lo, int j_hi, unsigned long long tmask,
                                           int qidx, int qlo_wave, unsigned W, unsigned long long own, f32x16* o, float& m_reg, float& l_reg,
                                           int imp_row  , const int wid) {
    const int tid = tid_of(wid), lane = tid & 63, r32 = lane & 31, hi = lane >> 5;
    LAS unsigned char* ldsl = (LAS unsigned char*)(unsigned)(uintptr_t)lds;
    const int vb0 = (int)(uintptr_t)(lds + L_V) + v_rd_base(lane), vb2 = (int)(uintptr_t)(lds + vb_off(2)) + v_rd_base(lane);
    float* wsf = (float*)(lds + L_WS) + wid * 64;
    const char* K_lds = lds;
    DmaOff dof; dma_offsets(dof, src, wid, lane);
    auto next_tile = [&](int j) -> int { if (MODE == MODE_SEL) { while (j < j_hi && !((tmask >> j) & 1ull)) ++j; } return j; };
    int j = next_tile(j_lo);
    if (j >= j_hi) { __syncthreads(); return; }
    constexpr bool RING = (MODE == MODE_BAND || MODE == MODE_SEL);
    int jnx = j_hi;
    if constexpr (PREF) { if constexpr (RING) jnx = next_tile(j + 1); asm volatile("s_waitcnt vmcnt(0)" ::: "memory"); }
    else {
        dma_issue<0>(dof, src, j * 64, ldsl, wid);
        if constexpr (RING) { jnx = next_tile(j + 1); if (jnx < j_hi) { dma_issue<1>(dof, src, jnx * 64, ldsl, wid); asm volatile("s_waitcnt vmcnt(4)" ::: "memory"); } else asm volatile("s_waitcnt vmcnt(0)" ::: "memory"); }
        else asm volatile("s_waitcnt vmcnt(0)" ::: "memory");
    }
    __syncthreads();
    float carry = 0.f;
    const float rl = (MODE == MODE_IMP) ? (l_reg > 0.f ? 1.f / l_reg : 0.f) : 0.f;
#define FA_STEP(KB) { \
        int jn; bool more; bool issued_ = false; \
        if constexpr (RING) { jn = jnx; more = jn < j_hi; const int j2_ = more ? next_tile(jn + 1) : j_hi; issued_ = j2_ < j_hi; if (issued_) dma_issue<(KB + 2) % 3>(dof, src, j2_ * 64, ldsl, wid); jnx = j2_; } \
        else { jn = next_tile(j + 1); more = jn < j_hi; if (more) dma_issue<1 - (KB & 1)>(dof, src, jn * 64, ldsl, wid); } \
        SBAR(); \
        f32x16 p0, p1; \
        const int kb_ = j * 64; \
        const bool act = (MODE != MODE_BAND) || (kb_ <= qlo_wave + 31 && kb_ + 63 + (int)W > qlo_wave); \
        if (act) { \
            qkt<KB>(p0, p1, K_lds, r32, hi, qr, (MODE == MODE_SEL && !((own >> j) & 1ull)) ? -__builtin_inff() : 0.f);     \
            if (MODE == MODE_SEL) { if (kb_ + 63 > qlo_wave) mask_tile(p0, p1, qidx - kb_ - 4 * hi, 0x7fffffffu); } \
            else { if (kb_ + 63 > qlo_wave || kb_ + (int)W <= qlo_wave + 31) mask_tile(p0, p1, qidx - kb_ - 4 * hi, W); } \
            if (MODE == MODE_IMP) { \
                const float mnL = -m_reg * C2; \
                _Pragma("unroll") for (int r = 0; r < 16; ++r) { p0[r] = __builtin_amdgcn_exp2f(fmaf(p0[r], C2, mnL)) * rl; p1[r] = __builtin_amdgcn_exp2f(fmaf(p1[r], C2, mnL)) * rl; } \
                float G0[4], G1[4], PL0[4], PL1[4]; \
                _Pragma("unroll") for (int g4 = 0; g4 < 4; ++g4) { G0[g4] = (p0[4 * g4] + p0[4 * g4 + 1]) + (p0[4 * g4 + 2] + p0[4 * g4 + 3]); G1[g4] = (p1[4 * g4] + p1[4 * g4 + 1]) + (p1[4 * g4 + 2] + p1[4 * g4 + 3]); \
                    PL0[g4] = __shfl_xor(p0[4 * g4 + 3], 32); PL1[g4] = __shfl_xor(p1[4 * g4 + 3], 32); } \
                float* ip = (float*)(lds + L_IMP) + imp_row * 64 + (j - j_lo) * 16; \
                _Pragma("unroll") for (int g4 = 0; g4 < 4; ++g4) { \
                    const float prev0 = hi ? PL0[g4] : (g4 ? PL0[g4 - 1] : carry); \
                    const float prev1 = hi ? PL1[g4] : (g4 ? PL1[g4 - 1] : PL0[3]); \
                    ip[2 * g4 + hi] = G0[g4] + prev0; ip[8 + 2 * g4 + hi] = G1[g4] + prev1; } \
                carry = PL1[3]; \
            } else { \
                float mn, alpha; partialSM(p0, p1, m_reg, mn, alpha); \
                if (MODE != MODE_STATS) { if (__any(alpha < 1.f)) { if (hi == 0) wsf[r32] = alpha; asm volatile("s_waitcnt lgkmcnt(0)" ::: "memory"); \
                    _Pragma("unroll") for (int d_ = 0; d_ < 4; ++d_) _Pragma("unroll") for (int r = 0; r < 16; ++r) o[d_][r] *= wsf[crow(r, hi)]; } } \
                bf16x8 pa0, pa1, pa2, pa3; finishSM(p0, p1, alpha, l_reg, pa0, pa1, pa2, pa3); SBAR(); \
                if (MODE != MODE_STATS) pv_tile<KB>(o, vb0, vb2, pa0, pa1, pa2, pa3); \
            } \
        } \
        if (RING && issued_) asm volatile("s_waitcnt vmcnt(4)" ::: "memory"); else asm volatile("s_waitcnt vmcnt(0)" ::: "memory");     \
        __syncthreads(); \
        if (!more) break; \
        j = jn; }
    if constexpr (RING) { for (;;) { FA_STEP(0) FA_STEP(1) FA_STEP(2) } } else { for (;;) { FA_STEP(0) FA_STEP(1) } }
#undef FA_STEP
}
}
namespace fa {
constexpr unsigned W_INF = 1u << 20;
__device__ __forceinline__ int opq_s(int x) { asm volatile("" : "+s"(x)); return x; }
__device__ __forceinline__ int opq_v(int x) { asm volatile("" : "+v"(x)); return x; }
template <int EMODE>
__device__ __forceinline__ void branch_epilogue(const f32x16* o, float sc_row, float* wsf, float* scratch, bf16_t* outw  , int ldo, int r32, int hi, int tid) {
    if (hi == 0) wsf[r32] = sc_row;
    asm volatile("s_waitcnt lgkmcnt(0)" ::: "memory");
    float rs[16];
#pragma unroll
    for (int r = 0; r < 16; ++r) rs[r] = wsf[crow(r, hi)];
    const unsigned voff = (unsigned)tid * 16u;
#pragma unroll
    for (int rg = 0; rg < 4; ++rg) {
        f32x4 sv[4];
        if (EMODE == 1 || EMODE == 2) {
#pragma unroll
            for (int d0 = 0; d0 < 4; ++d0) sv[d0] = *(const f32x4*)((const char*)scratch + (rg * 4 + d0) * 8192 + voff);
        }
#pragma unroll
        for (int d0 = 0; d0 < 4; ++d0) {
            f32x4 v;
#pragma unroll
            for (int r4 = 0; r4 < 4; ++r4) v[r4] = o[d0][rg * 4 + r4] * rs[rg * 4 + r4];
            if (EMODE == 1 || EMODE == 2) v += sv[d0];
            if (EMODE == 0 || EMODE == 1) *(f32x4*)((char*)scratch + (rg * 4 + d0) * 8192 + voff) = v;
            else {
#pragma unroll
                for (int r4 = 0; r4 < 4; ++r4) { const float vn = __shfl_xor(v[r4], 1);
                    if ((r32 & 1) == 0) *(unsigned*)(outw + (size_t)crow(rg * 4 + r4, hi) * ldo + d0 * 32 + r32) = cvtpk(v[r4], vn); }
            }
        }
        asm volatile("" ::: "memory");
    }
    asm volatile("s_waitcnt lgkmcnt(0)" ::: "memory");
}

__device__ __forceinline__ void nsa_unit(char* lds, unsigned char* ws, int L, const int wid, const int probe = 0) {
    const int cur = 63 - (L & 63), bg = L >> 6, b = bg >> 1, g = bg & 1, t0 = cur * 64;
    const int tid = tid_of(wid), lane = tid & 63, r32 = lane & 31, hi = lane >> 5;
    const int r = wid >> 1, qh = (wid & 1) * 32, qi = qh + r32, t = t0 + qi;
    const unsigned char* pj = ws + WS_PROJ;
    bf16x8 qr[8];
#pragma unroll
    for (int d0 = 0; d0 < 8; ++d0) qr[d0] = *(const bf16x8*)((const bf16_t*)(pj + PJ_QN) + ((size_t)(b * 8 + g * 4 + r) * S_ + t) * 128 + d0 * 16 + hi * 8);
    float* wsf = (float*)(lds + L_WS) + wid * 64;
#define NSA_GATE(br) bf2f(((const bf16_t*)(ws + WS_PROJ + PJ_GL))[(size_t)(opq_s(b) * S_ + opq_v(t)) * 32 + g * 12 + r * 3 + (br)])
#define NSA_SCRATCH() ((float*)(ws + WS_SCR) + (size_t)opq_s((int)blockIdx.x) * (64 * 512))
#define NSA_OUTW() ((bf16_t*)(ws + (probe ? WS_MERGED : WS_ONSAB)) + (size_t)(opq_s(b) * S_ + t0 + qh) * 1024 + (g * 4 + r) * 128)
    f32x16 o[4]; float m_reg, l_reg;
#define FA_RESET() do { _Pragma("unroll") for (int d_ = 0; d_ < 4; ++d_) o[d_] = f32x16{}; m_reg = -1e30f; l_reg = 0.f; } while (0)
    {
        const bf16_t* kc = (const bf16_t*)(ws + WS_KCB) + (size_t)(b * 2 + g) * 256 * 128; const bf16_t* vc = (const bf16_t*)(ws + WS_VCB) + (size_t)(b * 2 + g) * 256 * 128;
        const KVSrc src{kc, vc, 128, 1, 0};
        const int qc = (t - 31) >> 4, qc_lo = (t0 + qh - 31) >> 4, ntc = (4 * cur + 3 + 63) >> 6;
        FA_RESET();
        run_branch<MODE_BAND>(lds, qr, src, 0, ntc, 0ull, qc, qc_lo, W_INF, 0ull, o, m_reg, l_reg, 0, wid);
        branch_prefetch<MODE_IMP>(lds, src, 0, ntc, 0ull, wid);
        { const float g0 = NSA_GATE(0); branch_epilogue<0>(o, l_reg > 0.f ? g0 / l_reg : 0.f, wsf, NSA_SCRATCH(), nullptr, 1024, r32, hi, tid); }
        run_branch<MODE_IMP, true>(lds, qr, src, 0, ntc, 0ull, qc, qc_lo, W_INF, 0ull, o, m_reg, l_reg, r * 64 + qi, wid);
    }
    const size_t hoff = (size_t)(b * 2 + g) * S_ * 128;
    const KVSrc wsrc{(const bf16_t*)(pj + PJ_KV + 4 * 16 * MiB) + hoff, (const bf16_t*)(pj + PJ_KV + 5 * 16 * MiB) + hoff, 128, 1, 0};
    const KVSrc ssrc{(const bf16_t*)(pj + PJ_KV + 2 * 16 * MiB) + hoff, (const bf16_t*)(pj + PJ_KV + 3 * 16 * MiB) + hoff, 128, 1, 0};
    const int wj_lo = cur >= 8 ? cur - 8 : 0;
    if (!(probe & 2)) branch_prefetch<MODE_BAND>(lds, wsrc, wj_lo, cur + 1, 0ull, wid);
    {
        const float* imp = (const float*)(lds + L_IMP); unsigned long long* selm = (unsigned long long*)(lds + L_SELM);
#pragma unroll 1
        for (int q8 = 0; q8 < 8; ++q8) {
            const int q = wid * 8 + q8, j = lane;
            float v = -1e30f;
            if (j <= cur) v = ((imp[(0 * 64 + q) * 64 + j] + imp[(1 * 64 + q) * 64 + j]) + imp[(2 * 64 + q) * 64 + j]) + imp[(3 * 64 + q) * 64 + j];
            if (j == 0 || j == cur || j == cur - 1) v = 1e9f;
            unsigned sb = __float_as_uint(v); sb = (sb & 0x80000000u) ? ~sb : (sb | 0x80000000u);
            const unsigned klo = (sb << 6) | (unsigned)(63 - j), khi = sb >> 26;
            const unsigned long long key = ((unsigned long long)khi << 32) | klo;
            int rank = 0;
#pragma unroll
            for (int i = 0; i < 64; ++i) {
                const unsigned long long ku = ((unsigned long long)(unsigned)__builtin_amdgcn_readlane((int)khi, i) << 32) | (unsigned)__builtin_amdgcn_readlane((int)klo, i);
                rank += (ku > key) ? 1 : 0; }
            const unsigned long long m = __ballot(rank < 16);
            if (lane == 0) selm[q] = m;
        }
        __syncthreads();
    }
    unsigned long long own, uni;
    {
        const unsigned long long* selm = (const unsigned long long*)(lds + L_SELM);
        own = selm[qi];
        unsigned long long x = selm[lane]; unsigned xl = (unsigned)x, xh = (unsigned)(x >> 32);
#pragma unroll
        for (int o_ = 1; o_ < 64; o_ <<= 1) { xl |= (unsigned)__shfl_xor((int)xl, o_); xh |= (unsigned)__shfl_xor((int)xh, o_); }
        uni = ((unsigned long long)(unsigned)__builtin_amdgcn_readfirstlane((int)xh) << 32) | (unsigned)__builtin_amdgcn_readfirstlane((int)xl);
    }
    if (!(probe & 2)) {
        FA_RESET();
        run_branch<MODE_BAND, true>(lds, qr, wsrc, wj_lo, cur + 1, 0ull, t, t0 + qh, 512u, 0ull, o, m_reg, l_reg, 0, wid);
        if (!(probe & 1)) branch_prefetch<MODE_SEL>(lds, ssrc, 0, cur + 1, uni, wid);
        { const float g2 = NSA_GATE(2); branch_epilogue<1>(o, g2 / l_reg, wsf, NSA_SCRATCH(), nullptr, 1024, r32, hi, tid); }
    }
    if (!(probe & 1)) {
        FA_RESET();
        if (probe & 2) branch_prefetch<MODE_SEL>(lds, ssrc, 0, cur + 1, uni, wid);
        run_branch<MODE_SEL, true>(lds, qr, ssrc, 0, cur + 1, uni, t, t0 + qh, 0u, own, o, m_reg, l_reg, 0, wid);
        { const float g1 = NSA_GATE(1); branch_epilogue<2>(o, g1 / l_reg, wsf, NSA_SCRATCH(), NSA_OUTW(), 1024, r32, hi, tid); }
    }
#undef FA_RESET
#undef NSA_GATE
#undef NSA_SCRATCH
#undef NSA_OUTW
}

__device__ __forceinline__ void dil_unit(char* lds, unsigned char* ws, int L, const int wid) {
    const int cfg = L >> 9, rem = L & 511, bh = rem >> 4, pt = rem & 15, b = bh >> 2, h = bh & 3;
    const int dl = cfg * 2, d = 1 << dl, ntile = 16 >> dl;
    const int u = pt / ntile, p0 = (pt % ntile) * 256;
    const int tid = tid_of(wid), lane = tid & 63, r32 = lane & 31, hi = lane >> 5;
    const int p = p0 + wid * 32 + r32, tok = b * S_ + p * d + u;
    const unsigned char* pj = ws + WS_PROJ;
    const size_t hrow0 = (size_t)(b * 4 + h) * S_;
    const int ls = S_ >> dl;
    bf16x8 qr[8];
#pragma unroll
    for (int d0 = 0; d0 < 8; ++d0) qr[d0] = *(const bf16x8*)((const bf16_t*)(pj + PJ_DIL + (size_t)(cfg * 3 + 0) * 32 * MiB) + (hrow0 + (size_t)u * ls + p) * 128 + d0 * 16 + hi * 8);
    const KVSrc src{(const bf16_t*)(pj + PJ_DIL + (size_t)(cfg * 3 + 1) * 32 * MiB) + (hrow0 + (size_t)u * ls) * 128, (const bf16_t*)(pj + PJ_DIL + (size_t)(cfg * 3 + 2) * 32 * MiB) + (hrow0 + (size_t)u * ls) * 128, 128, 1, 0};
    f32x16 o[4];
#pragma unroll
    for (int d_ = 0; d_ < 4; ++d_) o[d_] = f32x16{};
    float m_reg = -1e30f, l_reg = 0.f;
    run_branch<MODE_BAND>(lds, qr, src, p0 >= 128 ? (p0 - 128) >> 6 : 0, (p0 >> 6) + 4, 0ull, p, p0 + wid * 32, 129u, 0ull, o, m_reg, l_reg, 0, wid);
    float* wsf = (float*)(lds + L_WS) + wid * 64;
    bf16_t* outw = (bf16_t*)(ws + WS_ODP) + (size_t)cfg * T_ * 512 + (size_t)(b * S_ + (p0 + wid * 32) * d + u) * 512 + h * 128;
    branch_epilogue<3>(o, 1.f / l_reg, wsf, nullptr, outw, 512 * d, r32, hi, tid);
    if (hi == 0) ((float*)(ws + WS_LSE))[(size_t)cfg * T_ * 4 + (size_t)tok * 4 + h] = m_reg * SCALE + logf(l_reg);
}

__device__ __forceinline__ void dil_combine(unsigned char* ws, int gt, int NGT) {
    const bf16_t* od = (const bf16_t*)(ws + WS_ODP); const float* lse = (const float*)(ws + WS_LSE); bf16_t* o = (bf16_t*)(ws + WS_ODILB);
    for (size_t i = (size_t)gt; i < (size_t)T_ * 64; i += NGT) {
        const size_t tok = i >> 6; const int c8 = (int)(i & 63) * 8, h = c8 >> 7;
        const float l0 = lse[tok * 4 + h], l1 = lse[(size_t)T_ * 4 + tok * 4 + h], l2 = lse[(size_t)2 * T_ * 4 + tok * 4 + h];
        const float m = fmaxf(l0, fmaxf(l1, l2)); float e0 = expf(l0 - m), e1 = expf(l1 - m), e2 = expf(l2 - m); const float inv = 1.f / (e0 + e1 + e2); e0 *= inv; e1 *= inv; e2 *= inv;
        const u32x4 a0 = *(const u32x4*)(od + tok * 512 + c8), a1 = *(const u32x4*)(od + (size_t)T_ * 512 + tok * 512 + c8), a2 = *(const u32x4*)(od + (size_t)2 * T_ * 512 + tok * 512 + c8);
        u32x4 w;
#pragma unroll
        for (int k = 0; k < 4; ++k) {
            const float lo = e0 * __uint_as_float(a0[k] << 16) + e1 * __uint_as_float(a1[k] << 16) + e2 * __uint_as_float(a2[k] << 16);
            const float hi_ = e0 * __uint_as_float(a0[k] & 0xffff0000u) + e1 * __uint_as_float(a1[k] & 0xffff0000u) + e2 * __uint_as_float(a2[k] & 0xffff0000u);
            w[k] = cvtpk(lo, hi_);
        }
        *(u32x4*)(o + tok * 512 + c8) = w;
    }
}

constexpr int CP_LD = 144;
constexpr int CP_A = 0, CP_B = 2 * 32 * CP_LD, CP_HID = CP_B + 2 * 256 * CP_LD, CP_HLD = 528;
static_assert(CP_HID + 32 * CP_HLD <= LDSCTL_OFF, "compress LDS map");
__device__ __forceinline__ void compress_unit(char* lds, unsigned char* ws, int unit, const int wid) {
    const int which = unit >> 7, R0 = (unit & 127) * 32;
    const int tid = tid_of(wid), lane = tid & 63, n32 = lane & 31, hi = lane >> 5;
    const bf16_t* w1t = (const bf16_t*)(ws + WS_CW1) + (size_t)which * 256 * 4096;
    const bf16_t* w2t = (const bf16_t*)(ws + WS_CW2) + (size_t)which * 128 * 256;
    const float* posb = (const float*)(ws + WS_POSB) + which * 16 * 256;
    const int ar = (tid >> 3) & 31, ap = tid & 7;
    const int Rr = R0 + ar, bgc = Rr >> 8, c = (Rr & 255) < 254 ? (Rr & 255) : 254, bb = bgc >> 1, gg = bgc & 1;
    const bf16_t* asrc = (const bf16_t*)(ws + WS_PROJ + PJ_KV + (size_t)(which ? 1 : 0) * 16 * MiB) + ((size_t)(bb * 2 + gg) * S_ + 16 * c) * 128 + ap * 8;
    bf16x8 sa0, sa1, sa2, sa3, sb0[4], sb1[4], sb2[4], sb3[4];
#define CP_LOAD(S, kt) do { if (tid < 256) sa##S = *(const bf16x8*)(asrc + (size_t)((kt) >> 1) * 128 + ((kt) & 1) * 64); \
        _Pragma("unroll") for (int i = 0; i < 4; ++i) { const int idx = tid + 512 * i; sb##S[i] = *(const bf16x8*)(w1t + (size_t)(idx >> 3) * 4096 + (kt) * 64 + (idx & 7) * 8); } } while (0)
#define CP_WRITE(S, bf) do { if (tid < 256) *(bf16x8*)(lds + CP_A + (bf) * 32 * CP_LD + ar * CP_LD + ap * 16) = sa##S; \
        _Pragma("unroll") for (int i = 0; i < 4; ++i) { const int idx = tid + 512 * i; *(bf16x8*)(lds + CP_B + (bf) * 256 * CP_LD + (idx >> 3) * CP_LD + (idx & 7) * 16) = sb##S[i]; } } while (0)
#define CP_STEP(k, LS, WS) do { const int k_ = (k); \
        if (k_ + 3 < 64) CP_LOAD(LS, k_ + 3); \
        { const char* ab = lds + CP_A + (k_ & 1) * 32 * CP_LD + n32 * CP_LD + hi * 16; \
          const char* bbp = lds + CP_B + (k_ & 1) * 256 * CP_LD + (wid * 32 + n32) * CP_LD + hi * 16; \
          _Pragma("unroll") for (int ks = 0; ks < 4; ++ks) { const bf16x8 af = *(const bf16x8*)(ab + ks * 32), bfv = *(const bf16x8*)(bbp + ks * 32); acc = __builtin_amdgcn_mfma_f32_32x32x16_bf16(af, bfv, acc, 0, 0, 0); } } \
        if (k_ + 1 < 64) { if (k_ + 3 < 64) asm volatile("s_waitcnt vmcnt(8)" ::: "memory"); else if (k_ + 2 < 64) asm volatile("s_waitcnt vmcnt(4)" ::: "memory"); else asm volatile("s_waitcnt vmcnt(0)" ::: "memory"); \
            CP_WRITE(WS, (k_ + 1) & 1); } \
        __syncthreads(); } while (0)
    f32x16 acc = f32x16{};
    CP_LOAD(0, 0); CP_LOAD(1, 1); CP_LOAD(2, 2);
    asm volatile("s_waitcnt vmcnt(8)" ::: "memory"); CP_WRITE(0, 0); __syncthreads();
#pragma unroll 1
    for (int kt = 0; kt < 64; kt += 4) {
        CP_STEP(kt, 3, 1); CP_STEP(kt + 1, 0, 2); CP_STEP(kt + 2, 1, 3); CP_STEP(kt + 3, 2, 0);
    }
#undef CP_LOAD
#undef CP_WRITE
#undef CP_STEP
    { float pb = 0.f;
#pragma unroll
      for (int c = 0; c < 16; ++c) pb += posb[c * 256 + wid * 32 + n32];
#pragma unroll
      for (int r = 0; r < 16; ++r) { const float hv = gelu_tanh(acc[r] + pb); const unsigned pk = cvtpk(hv, 0.f); *(bf16_t*)(lds + CP_HID + crow(r, hi) * CP_HLD + (wid * 32 + n32) * 2) = (bf16_t)pk; } }
    __syncthreads();
    if (wid < 4) {
        f32x16 a2 = f32x16{};
#pragma unroll
        for (int ks = 0; ks < 16; ++ks) {
            const bf16x8 af = *(const bf16x8*)(lds + CP_HID + n32 * CP_HLD + ks * 32 + hi * 16);
            const bf16x8 bfv = *(const bf16x8*)(w2t + (size_t)(wid * 32 + n32) * 256 + ks * 16 + hi * 8);
            a2 = __builtin_amdgcn_mfma_f32_32x32x16_bf16(af, bfv, a2, 0, 0, 0);
        }
        bf16_t* outp = (bf16_t*)(ws + (which ? WS_VCB : WS_KCB));
#pragma unroll
        for (int r = 0; r < 16; ++r) { const float v = a2[r], vn = __shfl_xor(v, 1);
            if ((n32 & 1) == 0) *(unsigned*)(outp + (size_t)(R0 + crow(r, hi)) * 128 + wid * 32 + n32) = cvtpk(v, vn); }
    }
    __syncthreads();
}
}
#ifndef F8_FUDGE
#define F8_FUDGE 1.f
#endif
#ifndef PROBE_NSA_FLAGS
#define PROBE_NSA_FLAGS 0
#endif
#ifndef PROBE_ATT_PART
#define PROBE_ATT_PART 0
#endif
#ifndef PROBE_DUP
#define PROBE_DUP (-1)
#endif
#define REPS(ph) for (int rep_ = 0; rep_ < ((PROBE_DUP) == (ph) ? 2 : 1); ++rep_)
enum { PH_PROLOGUE = 0, PH_INPROJ, PH_COMPRESS, PH_ATTN, PH_BRA, PH_BRB, PH_WOUT, PH_LN1, PH_SCATTER, PH_UP, PH_DOWN, PH_FINAL, PH_COUNT };
__global__ void __launch_bounds__(NWAVES * 64, 2) mk_fwd(Args args) {
    extern __shared__ __attribute__((aligned(16))) unsigned char lds_raw[];
    Frame F;
    F.lds = (LAS unsigned char*)lds_raw;
    F.MISC = (volatile LAS unsigned*)(F.lds + MISC_OFF);
    F.tid = threadIdx.x; F.lane = F.tid & 63; F.wave = __builtin_amdgcn_readfirstlane(F.tid >> 6);
    F.G = gridDim.x; { const int bx = blockIdx.x; F.vcu = (F.G % 8 == 0) ? (bx % 8) * (F.G / 8) + bx / 8 : bx; }
    unsigned char* ws = args.ws;
    F.ctl = (unsigned*)(ws + WS_CTL);
    for (int u = F.tid; u < (LDS_BYTES - LDSCTL_OFF) / 4; u += NWAVES * 64) ((LAS unsigned*)(F.lds + LDSCTL_OFF))[u] = 0u;
    __syncthreads();
    XcdBarrier bar = xcd_barrier_post(F.ctl + CW_BAR + args.li * XCD_BAR_WORDS, F.MISC + 8);
    const int lo = args.ph_lo, hi = args.ph_hi;
#define IN(k) (lo <= (k) && (k) < hi)
#define REFRAME() do { const int t_ = tid_of(F.wave); F.tid = t_; F.lane = t_ & 63; } while (0)
#define BOTH(k) (IN(k) && IN((k) + 1))
    if (IN(PH_PROLOGUE)) { REFRAME(); REPS(PH_PROLOGUE) p0_prologue(F, args); if (BOTH(PH_PROLOGUE)) xcd_barrier(bar, tid_of(F.wave) == 0); }
    if (IN(PH_INPROJ)) {
        pg8::Gemm g{(const bf16_t*)(ws + WS_XB), (const bf16_t*)(ws + WS_WIN), DM, nullptr};
        pg8::StaticOrder S; S.init(T_ / 256, 44, F.G, (int)blockIdx.x);
        pg8::EpiInProj E{ws + WS_PROJ, (const float*)(ws + WS_BINP), (const float*)(ws + WS_ROPE), (const float*)(ws + WS_ROPE) + 4096 * 64};
        REPS(PH_INPROJ) pg8::gemm_phase<pg8::EpiInProj, pg8::StaticOrder, false>(F.lds + RING_OFF, g, S, E, F.wave);
#ifdef PROBE_NULL_INPROJ
        { pg8::EpiNull EN; pg8::gemm_phase<pg8::EpiNull, pg8::StaticOrder, false>(F.lds + RING_OFF, g, S, EN, F.wave); }
#endif
        if (BOTH(PH_INPROJ)) xcd_barrier(bar, tid_of(F.wave) == 0);
    }
    if (IN(PH_COMPRESS)) { REFRAME();
        REPS(PH_COMPRESS) for (int u = (int)blockIdx.x; u < 256; u += F.G) fa::compress_unit((char*)lds_raw, ws, u, F.wave);
        if (BOTH(PH_COMPRESS)) xcd_barrier(bar, tid_of(F.wave) == 0);
    }
    if (IN(PH_ATTN)) { REFRAME();
        volatile LAS int* qslot = (volatile LAS int*)(F.lds + fa::L_MISC);
        LAS float* tscr = (LAS float*)(F.lds + F.wave * SCR_WAVE_BYTES);
#define MOE_W_POP() ({ if (F.tid == 0) qslot[1] = (int)atomicAdd(F.ctl + CW_QUEUE + 256 + rep_ * 16, (unsigned)MOE_W_BATCH); __syncthreads(); const int i0_ = __builtin_amdgcn_readfirstlane(qslot[1]); __syncthreads(); \
            moe_w_batch(args, i0_, (i0_ + MOE_W_BATCH < MOE_W_ITEMS ? i0_ + MOE_W_BATCH : MOE_W_ITEMS), tscr, F.wave, F.lane); __syncthreads(); i0_ < MOE_W_ITEMS; })
        REPS(PH_ATTN) {
        bool more_w = true;
        if ((((int)blockIdx.x >> 3) & 3) == 0) {
#pragma unroll 1
            while (more_w) more_w = MOE_W_POP();
        }
#pragma unroll 1
        for (;;) {
            if (F.tid == 0) qslot[0] = (int)atomicAdd(F.ctl + CW_QUEUE + rep_ * 128, 1u);
            __syncthreads();
            const int L = __builtin_amdgcn_readfirstlane(qslot[0]);
            __syncthreads();
            if (L >= 1024) break;
            if (rep_ == 1 && (PROBE_ATT_PART == 2 || PROBE_ATT_PART == 3)) continue;
            fa::nsa_unit((char*)lds_raw, ws, L, F.wave, rep_ == 1 ? PROBE_NSA_FLAGS : 0);
        }
        int ndil = 0;
#pragma unroll 1
        for (;;) {
            if (F.tid == 0) qslot[0] = (int)atomicAdd(F.ctl + CW_QUEUE + 64 + rep_ * 128, 1u);
            __syncthreads();
            const int L = __builtin_amdgcn_readfirstlane(qslot[0]);
            __syncthreads();
            if (L >= 1536) break;
            if (rep_ == 1 && (PROBE_ATT_PART == 1 || PROBE_ATT_PART == 3)) continue;
            fa::dil_unit((char*)lds_raw, ws, L, F.wave);
        }
#pragma unroll 1
        while (more_w) more_w = MOE_W_POP();
        }
#undef MOE_W_POP
        if (BOTH(PH_ATTN)) xcd_barrier(bar, tid_of(F.wave) == 0);
    }
    if (IN(PH_BRA)) { REFRAME();
        fa::dil_combine(ws, (F.vcu * NWAVES + F.wave) * 64 + F.lane, F.G * NWAVES * 64);
        xcd_barrier(bar, tid_of(F.wave) == 0);
        pg8::Gemm g{(const bf16_t*)(ws + WS_ONSAB), (const bf16_t*)(ws + WS_WBA), 1024, nullptr, (const bf16_t*)(ws + WS_ODILB), (const bf16_t*)(ws + WS_WBD), 512};
        pg8::StaticOrder S; S.init(T_ / 256, DM / 256, F.G, (int)blockIdx.x);
        pg8::EpiBr2 E{(bf16_t*)(ws + WS_MERGED), (const bf16_t*)(ws + WS_PROJ + PJ_GA), (const bf16_t*)(ws + WS_PROJ + PJ_GB)};
        REPS(PH_BRA) pg8::gemm_phase<pg8::EpiBr2, pg8::StaticOrder, false, false, true>(F.lds + RING_OFF, g, S, E, F.wave);
        if (BOTH(PH_BRA)) xcd_barrier(bar, tid_of(F.wave) == 0);
    }
    if (IN(PH_BRB)) { }
    if (IN(PH_WOUT)) {
        pg8::Gemm g{(const bf16_t*)(ws + WS_MERGED), (const bf16_t*)(ws + WS_WOUT), DM, nullptr};
        pg8::StaticOrder S; S.init(T_ / 256, DM / 256, F.G, (int)blockIdx.x);
        pg8::EpiWout E{(bf16_t*)(ws + WS_Z)};
        REPS(PH_WOUT) pg8::gemm_phase<pg8::EpiWout, pg8::StaticOrder, false>(F.lds + RING_OFF, g, S, E, F.wave);
        if (BOTH(PH_WOUT)) xcd_barrier(bar, tid_of(F.wave) == 0);
    }
    if (IN(PH_LN1)) { REFRAME(); p_ln1_router(F, args); if (BOTH(PH_LN1)) xcd_barrier(bar, tid_of(F.wave) == 0); }
    if (IN(PH_SCATTER)) { REFRAME(); p_scatter(F, args); if (BOTH(PH_SCATTER)) xcd_barrier(bar, tid_of(F.wave) == 0); }
    if (IN(PH_UP)) {
        const int ntiles = (int)__hip_atomic_load(F.ctl + CW_NTILES, __ATOMIC_RELAXED, __HIP_MEMORY_SCOPE_AGENT);
        pg8::Gemm g{(const bf16_t*)(ws + WS_HB), (const bf16_t*)(ws + WS_WUP), DM, (const int*)(ws + WS_ROUTE + 4 * 512 * 1024)};
        { LAS unsigned* tel = (LAS unsigned*)(F.lds + RING_BYTES); for (int i = F.tid; i < MOE_TILES; i += NWAVES * 64) tel[i] = F.ctl[CW_TILEEXP + i]; __syncthreads(); }
        pg8::ExpertOrder S; S.so.init(ntiles, 16, F.G, (int)blockIdx.x); S.tile_exp = (const LAS unsigned*)(F.lds + RING_BYTES);
        pg8::EpiSwigluT<true> E{(unsigned char*)(ws + WS_ACT), (const float*)(ws + WS_BUPP), 1.f / (W8_SCALE * F8_FUDGE)};
        REPS(PH_UP) pg8::gemm_phase<pg8::EpiSwigluT<true>, pg8::ExpertOrder, true, true>(F.lds + RING_OFF, g, S, E, F.wave);
#ifdef PROBE_NULL_UP
        { pg8::EpiNull EN; pg8::gemm_phase<pg8::EpiNull, pg8::ExpertOrder, true, true>(F.lds + RING_OFF, g, S, EN, F.wave); }
#endif
        if (BOTH(PH_UP)) xcd_barrier(bar, tid_of(F.wave) == 0);
    }
    if (IN(PH_DOWN)) {
        const int ntiles = (int)__hip_atomic_load(F.ctl + CW_NTILES, __ATOMIC_RELAXED, __HIP_MEMORY_SCOPE_AGENT);
        pg8::Gemm g{(const bf16_t*)(ws + WS_ACT), (const bf16_t*)(ws + WS_WDN), DM, nullptr};
        { LAS unsigned* tel = (LAS unsigned*)(F.lds + RING_BYTES); for (int i = F.tid; i < MOE_TILES; i += NWAVES * 64) tel[i] = F.ctl[CW_TILEEXP + i]; __syncthreads(); }
        pg8::ExpertOrderRev S; S.so.init(ntiles, 8, F.G, (int)blockIdx.x); S.tile_exp = (const LAS unsigned*)(F.lds + RING_BYTES);
        pg8::EpiDown E{(unsigned char*)(ws + WS_Y), args.in[19], (const float*)(ws + WS_ROUTE + 4 * 512 * 1024 + 544 * 1024), 1.f / (W8_SCALE * F8_FUDGE)};
        REPS(PH_DOWN) pg8::gemm_phase<pg8::EpiDown, pg8::ExpertOrderRev, false, true>(F.lds + RING_OFF, g, S, E, F.wave);
        if (BOTH(PH_DOWN)) xcd_barrier(bar, tid_of(F.wave) == 0);
    }
    if (IN(PH_FINAL)) { REFRAME(); REPS(PH_FINAL) p_final(F, args); }
#undef IN
#undef BOTH
}
static int g_grid = 0;
static void mk_launch(const Args& base, int lo, int hi, int li, hipStream_t stream) {
    Args a = base; a.ph_lo = lo; a.ph_hi = hi; a.li = li; a.pad = 0;
    hipLaunchKernelGGL(mk_fwd, dim3(g_grid), dim3(NWAVES * 64), LDS_BYTES, stream, a);
}
extern "C" void kernel_launch(void* const* d_in, const int* in_sizes, int n_in, void* d_out, int out_size, void* d_ws, size_t ws_size, hipStream_t stream) {
    if (g_grid == 0) {
        if (n_in != 22 || ws_size < WS_END) { fprintf(stderr, "kernel_launch: bad args n_in=%d ws=%zu need %zu\n", n_in, ws_size, (size_t)WS_END); g_grid = -1; return; }
        int dev = 0, cus = 0, per_cu = 0;
        if (hipGetDevice(&dev) != hipSuccess || hipDeviceGetAttribute(&cus, hipDeviceAttributeMultiprocessorCount, dev) != hipSuccess) { g_grid = -1; return; }
        if (hipFuncSetAttribute((const void*)mk_fwd, hipFuncAttributeMaxDynamicSharedMemorySize, LDS_BYTES) != hipSuccess) { fprintf(stderr, "hipFuncSetAttribute failed\n"); g_grid = -1; return; }
        if (hipOccupancyMaxActiveBlocksPerMultiprocessor(&per_cu, (const void*)mk_fwd, NWAVES * 64, LDS_BYTES) != hipSuccess || per_cu < 1) fprintf(stderr, "occupancy query: %d\n", per_cu);
        (void)hipGetLastError();
        g_grid = cus;
    }
    if (g_grid < 0) return;
    Args p{}; for (int i = 0; i < 22; ++i) p.in[i] = (const float*)d_in[i]; p.out = (float*)d_out; p.ws = (unsigned char*)d_ws;
    unsigned char* ws = p.ws;
    (void)hipMemsetAsync(ws + WS_CTL, 0, 1 * MiB, stream);
#ifndef MK_N_LAUNCHES
#define MK_N_LAUNCHES 1
#endif
    if (MK_N_LAUNCHES == 1) mk_launch(p, 0, PH_COUNT, 0, stream);
    else { mk_launch(p, PH_PROLOGUE, PH_INPROJ + 1, 0, stream); for (int ph = PH_COMPRESS; ph <= PH_FINAL; ++ph) mk_launch(p, ph, ph + 1, 1, stream); }
}
```

```cpp
#include <hip/hip_runtime.h>
#include <cstdio>
#include <cstdint>
#include <cmath>

constexpr int NB = 8, S_ = 4096, DM = 2048, T_ = NB * S_, HD = 128;
constexpr int IN_W = 11288, LDP = 11520;
constexpr int C_QN = 0, C_KC = 1024, C_VC = 1280, C_KS = 1536, C_VS = 1792, C_KW = 2048, C_VW = 2304;
constexpr int C_DIL = 2560;
constexpr int C_GA = 7168, C_GB = 9216, C_GL = 11264;
constexpr int NEXP = 32, TOPK = 4, MOE_ROWS = T_ * TOPK + NEXP * 256, MOE_TILES = MOE_ROWS / 256;
constexpr float DN_ALPHA = 1.189207115002721f;
constexpr float LN_EPS = 1e-5f;
constexpr float ATT_SCALE = 0.08838834764831845f;

__host__ __device__ __forceinline__ int wcol_of(int c) {
    if (c < 2560) return c;
    if (c < 11264) return c + 24;
    if (c < 11288) return c - 11264 + 2560;
    return -1;
}
__host__ __device__ __forceinline__ bool is_rope_tile(int pn) { return pn < 5 || pn == 6 || pn == 8 || (pn >= 10 && pn < 28 && ((pn - 10) % 6) < 4); }
__host__ __device__ __forceinline__ int inproj_phys2log(int pn, int p) { if (!is_rope_tile(pn)) return p; const int bj = p >> 7, hl = (p >> 6) & 1, d = p & 63; return hl * 128 + bj * 64 + d; }

typedef unsigned short bf16_t;
typedef short bf16x8 __attribute__((ext_vector_type(8)));
typedef float f32x4 __attribute__((ext_vector_type(4)));
typedef float f32x16 __attribute__((ext_vector_type(16)));
typedef unsigned u32x4 __attribute__((ext_vector_type(4)));
typedef unsigned u32x2 __attribute__((ext_vector_type(2)));
#define LAS __attribute__((address_space(3)))
#define GAS __attribute__((address_space(1)))

__device__ __forceinline__ float bf2f(bf16_t v) { return __uint_as_float((unsigned)v << 16); }
__device__ __forceinline__ unsigned cvt_pk_bf16(float lo, float hi) { unsigned r; asm volatile("v_cvt_pk_bf16_f32 %0, %1, %2" : "=v"(r) : "v"(lo), "v"(hi)); return r; }
__device__ __forceinline__ float sigm(float x) { return 1.f / (1.f + expf(-x)); }
__device__ __forceinline__ float sigm_fast(float x) { return __builtin_amdgcn_rcpf(1.f + __builtin_amdgcn_exp2f(-1.4426950408889634f * x)); }
__device__ __forceinline__ float gelu_tanh(float x) { return 0.5f * x * (1.f + tanhf(0.7978845608028654f * (x + 0.044715f * x * x * x))); }
__device__ __forceinline__ int tid_of(int wave) { int l; asm volatile("v_mbcnt_lo_u32_b32 %0, -1, 0\n\tv_mbcnt_hi_u32_b32 %0, -1, %0" : "=v"(l)); return (wave << 6) | l; }
__device__ __forceinline__ float wave_sum(float v) { for (int o = 1; o < 64; o <<= 1) v += __shfl_xor(v, o); return v; }

constexpr size_t MiB = 1ull << 20;
constexpr size_t WS_CTL = 0;
constexpr size_t WS_ROPE = 1 * MiB;
constexpr size_t WS_KC = 3 * MiB;
constexpr size_t WS_VC = 5 * MiB;
constexpr size_t WS_SELM = 7 * MiB;
constexpr size_t WS_ROUTE = 8 * MiB;
constexpr size_t WS_LSE = 12 * MiB;
constexpr size_t WS_BINP = 14 * MiB;
constexpr size_t WS_BUPP = WS_BINP + 64 * 1024;
constexpr size_t WS_KCB = 15 * MiB;
constexpr size_t WS_VCB = 16 * MiB;
constexpr size_t WS_W = 20 * MiB;
constexpr size_t WS_WIN = WS_W;
constexpr size_t WS_WBA = WS_WIN + 45 * MiB;
constexpr size_t WS_WBD = WS_WBA + 4 * MiB;
constexpr size_t WS_WOUT = WS_WBD + 2 * MiB;
constexpr size_t WS_CW1 = WS_WOUT + 8 * MiB;
constexpr size_t WS_CW2 = WS_CW1 + 4 * MiB;
constexpr size_t WS_WUP = WS_CW2 + 1 * MiB;
constexpr size_t WS_WDN = WS_WUP + 512 * MiB;
constexpr size_t WS_XB = WS_WDN + 256 * MiB;
constexpr size_t WS_PROJ = WS_XB + 128 * MiB;
constexpr size_t WS_ONSA = WS_PROJ + 720 * MiB;
constexpr size_t WS_ODP = WS_ONSA + 128 * MiB;
constexpr size_t WS_ODIL = WS_ODP + 192 * MiB;
constexpr size_t WS_MERGED = WS_ODIL + 64 * MiB;
constexpr size_t WS_Z = WS_MERGED + 256 * MiB;
constexpr size_t WS_HB = WS_Z + 256 * MiB;
constexpr size_t PJ_QN = 0;
constexpr size_t PJ_KV = 64 * MiB;
constexpr size_t PJ_DIL = 160 * MiB;
constexpr size_t PJ_GA = 448 * MiB;
constexpr size_t PJ_GB = 576 * MiB;
constexpr size_t PJ_GL = 704 * MiB;
__host__ __device__ __forceinline__ int dil_row(int cfg, int t) { const int dl = 2 * cfg; return ((t & ((1 << dl) - 1)) << (12 - dl)) + (t >> dl); }
constexpr size_t WS_ONSAB = WS_ONSA;
constexpr size_t WS_ODILB = WS_ODIL;
constexpr size_t WS_SCR = WS_MERGED + 128 * MiB;
constexpr size_t WS_POSB = WS_BUPP + 512 * 1024;
constexpr size_t WS_ACT = WS_PROJ;
constexpr size_t WS_Y = WS_HB + 128 * MiB;
constexpr size_t WS_WRT = WS_POSB + 64 * 1024;
constexpr size_t WS_H = WS_Y + 600 * MiB;
constexpr size_t WS_END = WS_Y + 1088 * MiB;
static_assert(WS_END <= 4096 * MiB, "ws map");
constexpr int CW_CNT = 64;
constexpr int CW_NTILES = 128;
constexpr int CW_PADSTART = 192;
constexpr int CW_TILEEXP = 256;
constexpr int CW_TEST = 960;
constexpr int CW_QUEUE = 1024;
constexpr int CW_BAR = 4096;

struct Args { const float* in[22]; float* out; unsigned char* ws; int ph_lo, ph_hi, li, pad; };
typedef Args P;
#ifndef F8_EXPERIMENT
#define F8_EXPERIMENT 0
#endif
namespace pg8 {
typedef int v4i_t __attribute__((ext_vector_type(4)));
typedef int v8i_t __attribute__((ext_vector_type(8)));
#define PG8_LAS __attribute__((address_space(3)))
constexpr int BM = 256, BK = 64, HALF = 128, HTB = HALF * BK * 2, STAGE_BYTES = 8 * HTB, NXCD = 8, WGM = 8;
__host__ __device__ __forceinline__ int lds_byte(int r, int c) { const int st = (r >> 4) * 2 + (c >> 5), rr = r & 15, cc = c & 31, ob = rr * 64 + cc * 2; return st * 1024 + (ob ^ (((ob >> 9) & 1) << 5)); }
__host__ __device__ __forceinline__ void stage_rc(int b, int& R, int& C) { const int st = b / 1024, sb = b % 1024, swz = sb ^ (((sb >> 9) & 1) << 5); R = (st >> 1) * 16 + swz / 64; C = (st & 1) * 32 + (swz % 64) / 2; }
__host__ __device__ __forceinline__ int perm32(int rho) { const int n = rho >> 4, i = rho & 15; return 8 * (i >> 2) + 4 * n + (i & 3); }

struct Unit { int pm, pn, pb; };
struct Gemm { const bf16_t* A; const bf16_t* Bt; int K; const int* arows; const bf16_t* A2 = nullptr; const bf16_t* Bt2 = nullptr; int K2 = 0; };

struct StaticOrder {
    int nM, nN, nwg, G, c;
    __device__ void init(int nM_, int nN_, int G_, int c_) { nM = nM_; nN = nN_; nwg = nM * nN; G = G_; c = c_; }
    __device__ bool next(int i, Unit& u) const {
        const long L = (long)i * G + c; if (L >= nwg) return false;
        int wgid = (int)L; { const int q = nwg / NXCD, r = nwg % NXCD, xcd = wgid % NXCD, off = wgid / NXCD; wgid = (xcd < r ? xcd * (q + 1) : r * (q + 1) + (xcd - r) * q) + off; }
        const int nig = WGM * nN, gid = wgid / nig, fm = gid * WGM, gsz = (nM - fm) < WGM ? (nM - fm) : WGM;
        u.pm = fm + ((wgid % nig) % gsz); u.pn = (wgid % nig) / gsz; u.pb = u.pn; return true;
    }
};
struct ExpertOrder {
    StaticOrder so; const PG8_LAS unsigned* tile_exp;
    __device__ bool next(int i, Unit& u) const { if (!so.next(i, u)) return false; u.pb = (int)tile_exp[u.pm] * so.nN + u.pn; return true; }
};

template <class Epi, class Sched, bool GATHER, bool F8 = false, bool SEG2 = false>
__device__ __forceinline__ void gemm_phase(PG8_LAS unsigned char* lds, const Gemm g, const Sched& S, const Epi& E, const int wid) {
    const int tid = tid_of(wid), lane = tid & 63, wr = wid >> 2, wc = wid & 3, fr = lane & 15, fq = lane >> 4;
    const int K = g.K, RB = F8 ? K : K * 2, nt1 = F8 ? K / 128 : K / BK, RB2 = SEG2 ? g.K2 * 2 : RB, nt = SEG2 ? nt1 + g.K2 / BK : nt1;
    unsigned voffA[2], voffB[2], voffA2[2], voffB2[2]; int rA[2], cA2[2];
#pragma unroll
    for (int i = 0; i < 2; ++i) { int R, CB;
        { int C; stage_rc(tid * 16 + i * 8192, R, C); CB = C * 2; }
        const int Rb = (R & ~31) + perm32(R & 31);
        voffA[i] = (unsigned)(R * RB + CB); voffB[i] = (unsigned)(Rb * RB + CB); voffA2[i] = (unsigned)(R * RB2 + CB); voffB2[i] = (unsigned)(Rb * RB2 + CB); rA[i] = R; cA2[i] = CB; }
    const size_t kstep = 128;
    const size_t hstep = (size_t)HALF * RB;
    const size_t tstep = 2 * hstep;
    const size_t hstep2 = (size_t)HALF * RB2, tstep2 = 2 * hstep2;
    const unsigned ldsw = (unsigned)wid * 1024u;
    const int aoff = lds_byte(wr * 64 + fr, fq * 8), boff = lds_byte(wc * 32 + fr, fq * 8);
#define PG8_SA(b, h) (((b) * 2 + (h)) * HTB)
#define PG8_SB(b, h) ((4 + (b) * 2 + (h)) * HTB)
#define PG8_STAGE(bufoff, gbase, voff) do { _Pragma("unroll") for (int _i = 0; _i < 2; ++_i) \
        __builtin_amdgcn_global_load_lds((const unsigned*)((const char*)(gbase) + (voff)[_i]), (PG8_LAS unsigned*)(lds + (bufoff) + ldsw + _i * 8192), 16, 0, 0); } while (0)
#define PG8_STAGE_A(bufoff, gbase, h, par) do { if constexpr (GATHER) { unsigned vg_[2]; _Pragma("unroll") for (int _i = 0; _i < 2; ++_i) vg_[_i] = rowtab[(par) * 256 + (h) * HALF + rA[_i]] * (unsigned)RB + (unsigned)cA2[_i]; PG8_STAGE(bufoff, gbase, vg_); } \
        else { PG8_STAGE(bufoff, (gbase) + (h) * hstep, voffA); } } while (0)
#define PG8_STAGE_AX(bufoff, gbase, h, par, HS, VO) do { if constexpr (GATHER) { PG8_STAGE_A(bufoff, gbase, h, par); } else { PG8_STAGE(bufoff, (gbase) + (h) * (HS), VO); } } while (0)
#define PG8_LDA(dst, b, h) do { _Pragma("unroll") for (int m = 0; m < 4; ++m) { dst[m].lo = *(const PG8_LAS v4i_t*)(lds + PG8_SA(b, h) + aoff + m * 2048); dst[m].hi = *(const PG8_LAS v4i_t*)(lds + PG8_SA(b, h) + aoff + m * 2048 + 1024); } } while (0)
#define PG8_LDB(dst, b, h) do { _Pragma("unroll") for (int n = 0; n < 2; ++n) { dst[n].lo = *(const PG8_LAS v4i_t*)(lds + PG8_SB(b, h) + boff + n * 2048); dst[n].hi = *(const PG8_LAS v4i_t*)(lds + PG8_SB(b, h) + boff + n * 2048 + 1024); } } while (0)
#define PG8_MMA(ai, bj, At, Bt) do { __builtin_amdgcn_s_setprio(1); _Pragma("unroll") for (int m = 0; m < 4; ++m) _Pragma("unroll") for (int n = 0; n < 2; ++n) { \
        if constexpr (F8) { if (F8_EXPERIMENT == 2) { _Pragma("unroll") for (int q = 0; q < 4; ++q) { \
                u32x4 bw, aw; _Pragma("unroll") for (int hh = 0; hh < 2; ++hh) { \
                    const auto b0 = __builtin_amdgcn_cvt_pk_f32_fp8(Bt[n][2 * q + hh], false), b1 = __builtin_amdgcn_cvt_pk_f32_fp8(Bt[n][2 * q + hh], true); \
                    const auto a0 = __builtin_amdgcn_cvt_pk_f32_fp8(At[m][2 * q + hh], false), a1 = __builtin_amdgcn_cvt_pk_f32_fp8(At[m][2 * q + hh], true); \
                    bw[2 * hh] = cvt_pk_bf16(b0[0], b0[1]); bw[2 * hh + 1] = cvt_pk_bf16(b1[0], b1[1]); aw[2 * hh] = cvt_pk_bf16(a0[0], a0[1]); aw[2 * hh + 1] = cvt_pk_bf16(a1[0], a1[1]); } \
                acc[ai][bj][m][n] = __builtin_amdgcn_mfma_f32_16x16x32_bf16(__builtin_bit_cast(bf16x8, bw), __builtin_bit_cast(bf16x8, aw), acc[ai][bj][m][n], 0, 0, 0); } } \
            else if (F8_EXPERIMENT == 1) { _Pragma("unroll") for (int q = 0; q < 4; ++q) { \
                const long bq = ((long)(unsigned)Bt[n][2 * q + 1] << 32) | (unsigned)Bt[n][2 * q], aq = ((long)(unsigned)At[m][2 * q + 1] << 32) | (unsigned)At[m][2 * q]; \
                acc[ai][bj][m][n] = __builtin_amdgcn_mfma_f32_16x16x32_fp8_fp8(bq, aq, acc[ai][bj][m][n], 0, 0, 0); } } \
            else asm volatile("v_mfma_f32_16x16x128_f8f6f4 %0, %1, %2, %0" : "+v"(acc[ai][bj][m][n]) : "v"(Bt[n]), "v"(At[m])); } \
        else { const v4i_t bl_ = Bt[n].lo, bh_ = Bt[n].hi, al_ = At[m].lo, ah_ = At[m].hi;     \
               acc[ai][bj][m][n] = __builtin_amdgcn_mfma_f32_16x16x32_bf16(__builtin_bit_cast(bf16x8, bl_), __builtin_bit_cast(bf16x8, al_), acc[ai][bj][m][n], 0, 0, 0); \
               acc[ai][bj][m][n] = __builtin_amdgcn_mfma_f32_16x16x32_bf16(__builtin_bit_cast(bf16x8, bh_), __builtin_bit_cast(bf16x8, ah_), acc[ai][bj][m][n], 0, 0, 0); } } \
        __builtin_amdgcn_s_setprio(0); } while (0)
#define PG8_WAIT_V(n) asm volatile("s_waitcnt vmcnt(" #n ")" ::: "memory")
#define PG8_WAIT_L(n) asm volatile("s_waitcnt lgkmcnt(" #n ")" ::: "memory")
#define PG8_BAR __builtin_amdgcn_s_barrier()
#define PG8_SCHED __builtin_amdgcn_sched_barrier(0)
    Unit cur, nxt; int ui = 0;
    if (!S.next(0, cur)) return;
    f32x4 acc[2][2][4][2];
#pragma unroll
    for (int a = 0; a < 2; ++a)
#pragma unroll
        for (int b = 0; b < 2; ++b)
#pragma unroll
            for (int m = 0; m < 4; ++m)
#pragma unroll
                for (int n = 0; n < 2; ++n) acc[a][b][m][n] = (f32x4){0.f, 0.f, 0.f, 0.f};
    v8i_t At[4], B0[2], B1[2];
    const PG8_LAS unsigned* rowtab = (const PG8_LAS unsigned*)(lds + STAGE_BYTES + 4096);
#define PG8_ROWTAB_FILL(u, par) do { if constexpr (GATHER) { if (wid < 4) __builtin_amdgcn_global_load_lds((const unsigned*)(g.arows + (u).pm * BM + wid * 64 + lane), (PG8_LAS unsigned*)(lds + STAGE_BYTES + 4096 + (par) * 1024 + wid * 256), 4, 0, 0); } } while (0)
    if constexpr (GATHER) { PG8_ROWTAB_FILL(cur, 0); PG8_WAIT_V(0); PG8_BAR; }
    const char* cA = GATHER ? (const char*)g.A : (const char*)g.A + (size_t)cur.pm * tstep; const char* cB = (const char*)g.Bt + (size_t)cur.pb * tstep;
    const char* cAs = SEG2 ? (const char*)g.A2 + (size_t)cur.pm * tstep2 : cA; const char* cBs = SEG2 ? (const char*)g.Bt2 + (size_t)cur.pb * tstep2 : cB;
    PG8_STAGE(PG8_SB(0, 0), cB, voffB); PG8_STAGE(PG8_SB(0, 1), cB + hstep, voffB); PG8_STAGE_A(PG8_SA(0, 0), cA, 0, 0); PG8_STAGE_A(PG8_SA(0, 1), cA, 1, 0);
    if (wr == 1) PG8_BAR;
    PG8_WAIT_V(2); PG8_BAR;
    PG8_STAGE(PG8_SB(1, 0), cB + kstep, voffB); PG8_STAGE_A(PG8_SA(1, 0), cA + kstep, 0, 0); PG8_STAGE(PG8_SB(1, 1), cB + hstep + kstep, voffB);
    PG8_WAIT_V(6); PG8_BAR;
    for (;;) {
        const bool has_next = S.next(ui + 1, nxt);
        const int parc = ui & 1;
        if (has_next) PG8_ROWTAB_FILL(nxt, parc ^ 1);
        const char* nA = GATHER ? (const char*)g.A : (has_next ? (const char*)g.A + (size_t)nxt.pm * tstep : cA); const char* nB = has_next ? (const char*)g.Bt + (size_t)nxt.pb * tstep : cB;
        for (int t = 0; t < nt; t += 2) {
            const bool last = (t == nt - 2);
            const bool c1 = SEG2 ? (t < nt1) : true, n1 = SEG2 ? (last || t + 2 < nt1) : true;
            const size_t hs_c = c1 ? hstep : hstep2, hs_n = n1 ? hstep : hstep2;
            unsigned vAc[2], vAn[2], vBn[2];
#pragma unroll
            for (int i = 0; i < 2; ++i) { vAc[i] = c1 ? voffA[i] : voffA2[i]; vAn[i] = n1 ? voffA[i] : voffA2[i]; vBn[i] = n1 ? voffB[i] : voffB2[i]; }
            const char* a1 = c1 ? cA + (size_t)(t + 1) * kstep : cAs + (size_t)(t + 1 - nt1) * kstep;
            const char* a2 = last ? nA : (n1 ? cA + (size_t)(t + 2) * kstep : cAs + (size_t)(t + 2 - nt1) * kstep); const char* b2 = last ? nB : (n1 ? cB + (size_t)(t + 2) * kstep : cBs + (size_t)(t + 2 - nt1) * kstep);
            const char* a3 = a2 + kstep; const char* b3 = b2 + kstep;
            if constexpr (SEG2) { if (t == nt1) { int fr_ = fr, fq_ = fq; asm volatile("" : "+v"(fr_), "+v"(fq_)); E.mid(acc, cur, wr, wc, fr_, fq_); } }
            const int par2 = (last && has_next) ? (parc ^ 1) : parc;
            PG8_LDB(B0, 0, 0); PG8_LDB(B1, 0, 1); PG8_SCHED; PG8_LDA(At, 0, 0); PG8_STAGE_AX(PG8_SA(1, 1), a1, 1, parc, hs_c, vAc);
            PG8_WAIT_V(8); PG8_WAIT_L(0); PG8_BAR; PG8_MMA(0, 0, At, B0); PG8_MMA(0, 1, At, B1); PG8_BAR; PG8_SCHED;
            PG8_LDA(At, 0, 1); PG8_STAGE(PG8_SB(0, 0), b2, vBn); PG8_STAGE(PG8_SB(0, 1), b2 + hs_n, vBn); PG8_STAGE_AX(PG8_SA(0, 0), a2, 0, par2, hs_n, vAn);
            PG8_WAIT_V(8); PG8_WAIT_L(0); PG8_BAR; PG8_MMA(1, 0, At, B0); PG8_MMA(1, 1, At, B1); PG8_BAR; PG8_SCHED;
            PG8_LDB(B0, 1, 0); PG8_LDB(B1, 1, 1); PG8_SCHED; PG8_LDA(At, 1, 0); PG8_STAGE_AX(PG8_SA(0, 1), a2, 1, par2, hs_n, vAn);
            PG8_WAIT_V(8); PG8_WAIT_L(0); PG8_BAR; PG8_MMA(0, 0, At, B0); PG8_MMA(0, 1, At, B1); PG8_BAR; PG8_SCHED;
            PG8_LDA(At, 1, 1); PG8_STAGE(PG8_SB(1, 0), b3, vBn); PG8_STAGE(PG8_SB(1, 1), b3 + hs_n, vBn); PG8_STAGE_AX(PG8_SA(1, 0), a3, 0, par2, hs_n, vAn);
            PG8_WAIT_V(8); PG8_WAIT_L(0); PG8_BAR; PG8_MMA(1, 0, At, B0); PG8_MMA(1, 1, At, B1); PG8_BAR; PG8_SCHED;
        }
        if (wr == 0) PG8_BAR;
        { int fr_ = fr, fq_ = fq; asm volatile("" : "+v"(fr_), "+v"(fq_)); E(acc, cur, wr, wc, fr_, fq_); }
        if (!has_next) break;
#pragma unroll
        for (int a = 0; a < 2; ++a)
#pragma unroll
            for (int b = 0; b < 2; ++b)
#pragma unroll
                for (int m = 0; m < 4; ++m)
#pragma unroll
                    for (int n = 0; n < 2; ++n) acc[a][b][m][n] = (f32x4){0.f, 0.f, 0.f, 0.f};
        cur = nxt; cA = nA; cB = nB; ++ui;
        if constexpr (SEG2) { cAs = (const char*)g.A2 + (size_t)cur.pm * tstep2; cBs = (const char*)g.Bt2 + (size_t)cur.pb * tstep2; }
        if (wr == 1) PG8_BAR;
    }
    PG8_WAIT_V(0);
    PG8_BAR;
#undef PG8_SA
#undef PG8_SB
#undef PG8_STAGE
#undef PG8_STAGE_A
#undef PG8_STAGE_AX
#undef PG8_LDA
#undef PG8_LDB
#undef PG8_MMA
#undef PG8_WAIT_V
#undef PG8_WAIT_L
#undef PG8_BAR
#undef PG8_SCHED
#undef PG8_ROWTAB_FILL
}

struct EpiInProj {
    unsigned char* pj; const float* biasp; const float* rc; const float* rs;
    __device__ __forceinline__ bf16_t* head_row(int pn, int hs, int b, int t) const {
        if (pn < 4) return (bf16_t*)(pj + PJ_QN) + ((size_t)(b * 8 + 2 * pn + hs) * S_ + t) * 128;
        if (pn < 10) return (bf16_t*)(pj + PJ_KV + (size_t)(pn - 4) * 16 * MiB) + ((size_t)(b * 2 + hs) * S_ + t) * 128;
        const int idx = pn - 10, cfg = idx / 6, part = (idx % 6) >> 1, half = idx & 1;
        return (bf16_t*)(pj + PJ_DIL + (size_t)(cfg * 3 + part) * 32 * MiB) + ((size_t)(b * 4 + 2 * half + hs) * S_ + dil_row(cfg, t)) * 128;
    }
    __device__ __forceinline__ void operator()(const f32x4 (&acc)[2][2][4][2], const Unit& u, int wr, int wc, int fr, int fq) const {
        const int pn = u.pn, pc = wc * 32 + fq * 8;
        const bool rope = is_rope_tile(pn), gate = pn >= 28;
        f32x4 bv[2][2];
#pragma unroll
        for (int bj = 0; bj < 2; ++bj)
#pragma unroll
            for (int n = 0; n < 2; ++n) bv[bj][n] = *(const f32x4*)(biasp + pn * 256 + bj * HALF + pc + 4 * n);
        if (rope) {
            const int hl = pc >> 6, d0 = pc & 63;
#pragma unroll
            for (int ai = 0; ai < 2; ++ai) {
                f32x4 C[4][2], S[4][2];
#pragma unroll
                for (int m = 0; m < 4; ++m) { const int t = (u.pm * BM + ai * HALF + wr * 64 + m * 16 + fr) & (S_ - 1);
#pragma unroll
                    for (int n = 0; n < 2; ++n) { C[m][n] = *(const f32x4*)(rc + t * 64 + d0 + 4 * n); S[m][n] = *(const f32x4*)(rs + t * 64 + d0 + 4 * n); } }
#pragma unroll
                for (int m = 0; m < 4; ++m) {
                    const int row = u.pm * BM + ai * HALF + wr * 64 + m * 16 + fr, t = row & (S_ - 1), b = row >> 12;
                    bf16_t* rowp = head_row(pn, hl, b, t) + d0;
                    u32x4 w1, w2;
#pragma unroll
                    for (int n = 0; n < 2; ++n) {
                        const f32x4 c = C[m][n], s = S[m][n];
                        const f32x4 x1 = acc[ai][0][m][n] + bv[0][n], x2 = acc[ai][1][m][n] + bv[1][n];
                        const f32x4 o1 = x1 * c - x2 * s, o2 = x2 * c + x1 * s;
                        w1[2 * n] = cvt_pk_bf16(o1[0], o1[1]); w1[2 * n + 1] = cvt_pk_bf16(o1[2], o1[3]);
                        w2[2 * n] = cvt_pk_bf16(o2[0], o2[1]); w2[2 * n + 1] = cvt_pk_bf16(o2[2], o2[3]);
                    }
                    *(u32x4*)rowp = w1; *(u32x4*)(rowp + 64) = w2;
                }
            }
        } else {
#pragma unroll
            for (int ai = 0; ai < 2; ++ai)
#pragma unroll
                for (int m = 0; m < 4; ++m) {
                    const int row = u.pm * BM + ai * HALF + wr * 64 + m * 16 + fr, t = row & (S_ - 1), b = row >> 12;
#pragma unroll
                    for (int bj = 0; bj < 2; ++bj) {
                        f32x4 v0 = acc[ai][bj][m][0] + bv[bj][0], v1 = acc[ai][bj][m][1] + bv[bj][1];
                        bf16_t* dst;
                        if (gate) {
#pragma unroll
                            for (int i = 0; i < 4; ++i) { v0[i] = sigm_fast(v0[i]); v1[i] = sigm_fast(v1[i]); }
                            if (pn < 36) dst = (bf16_t*)(pj + PJ_GA) + (size_t)row * DM + (pn - 28) * 256 + bj * HALF + pc;
                            else if (pn < 44) dst = (bf16_t*)(pj + PJ_GB) + (size_t)row * DM + (pn - 36) * 256 + bj * HALF + pc;
                            else dst = (bf16_t*)(pj + PJ_GL) + (size_t)row * 32 + pc;
                        } else dst = head_row(pn, bj, b, t) + pc;
                        u32x4 w; w.x = cvt_pk_bf16(v0[0], v0[1]); w.y = cvt_pk_bf16(v0[2], v0[3]); w.z = cvt_pk_bf16(v1[0], v1[1]); w.w = cvt_pk_bf16(v1[2], v1[3]);
                        if (pn < 44 || (bj == 0 && wc == 0)) *(u32x4*)dst = w;
                    }
                }
        }
    }
};
template <bool ACCUM> struct EpiBr {
    bf16_t* merged; const bf16_t* gbuf;
    __device__ __forceinline__ void operator()(const f32x4 (&acc)[2][2][4][2], const Unit& u, int wr, int wc, int fr, int fq) const {
        const int c0 = u.pn * BM + wc * 32 + fq * 8;
#pragma unroll
        for (int ai = 0; ai < 2; ++ai)
#pragma unroll
            for (int m = 0; m < 4; ++m) {
                const int row = u.pm * BM + ai * HALF + wr * 64 + m * 16 + fr;
#pragma unroll
                for (int bj = 0; bj < 2; ++bj) {
                    const u32x4 gw = *(const u32x4*)(gbuf + (size_t)row * DM + c0 + bj * HALF);
                    bf16_t* op = merged + (size_t)row * DM + c0 + bj * HALF;
                    u32x4 ow = {0u, 0u, 0u, 0u}; if (ACCUM) ow = *(const u32x4*)op;
                    u32x4 w;
#pragma unroll
                    for (int j = 0; j < 4; ++j) {
                        const f32x4& a = acc[ai][bj][m][j >> 1];
                        float v0 = __uint_as_float(gw[j] << 16) * a[(j & 1) * 2], v1 = __uint_as_float(gw[j] & 0xffff0000u) * a[(j & 1) * 2 + 1];
                        if (ACCUM) { v0 += __uint_as_float(ow[j] << 16); v1 += __uint_as_float(ow[j] & 0xffff0000u); }
                        w[j] = cvt_pk_bf16(v0, v1);
                    }
                    *(u32x4*)op = w;
                }
            }
    }
};
struct EpiBr2 {
    bf16_t* merged; const bf16_t* ga; const bf16_t* gb;
    __device__ __forceinline__ void mid(f32x4 (&acc)[2][2][4][2], const Unit& u, int wr, int wc, int fr, int fq) const {
        const int c0 = u.pn * BM + wc * 32 + fq * 8;
#pragma unroll
        for (int ai = 0; ai < 2; ++ai)
#pragma unroll
            for (int m = 0; m < 4; ++m) {
                const int row = u.pm * BM + ai * HALF + wr * 64 + m * 16 + fr;
#pragma unroll
                for (int bj = 0; bj < 2; ++bj) {
                    const u32x4 aw = *(const u32x4*)(ga + (size_t)row * DM + c0 + bj * HALF), bw = *(const u32x4*)(gb + (size_t)row * DM + c0 + bj * HALF);
#pragma unroll
                    for (int j = 0; j < 4; ++j) {
                        f32x4& a = acc[ai][bj][m][j >> 1];
                        a[(j & 1) * 2] *= __uint_as_float(aw[j] << 16) * __builtin_amdgcn_rcpf(fmaxf(__uint_as_float(bw[j] << 16), 1e-30f));
                        a[(j & 1) * 2 + 1] *= __uint_as_float(aw[j] & 0xffff0000u) * __builtin_amdgcn_rcpf(fmaxf(__uint_as_float(bw[j] & 0xffff0000u), 1e-30f));
                    }
                }
            }
    }
    __device__ __forceinline__ void operator()(const f32x4 (&acc)[2][2][4][2], const Unit& u, int wr, int wc, int fr, int fq) const {
        const int c0 = u.pn * BM + wc * 32 + fq * 8;
#pragma unroll
        for (int ai = 0; ai < 2; ++ai)
#pragma unroll
            for (int m = 0; m < 4; ++m) {
                const int row = u.pm * BM + ai * HALF + wr * 64 + m * 16 + fr;
#pragma unroll
                for (int bj = 0; bj < 2; ++bj) {
                    const u32x4 gw = *(const u32x4*)(gb + (size_t)row * DM + c0 + bj * HALF);
                    u32x4 w;
#pragma unroll
                    for (int j = 0; j < 4; ++j) {
                        const f32x4& a = acc[ai][bj][m][j >> 1];
                        w[j] = cvt_pk_bf16(__uint_as_float(gw[j] << 16) * a[(j & 1) * 2], __uint_as_float(gw[j] & 0xffff0000u) * a[(j & 1) * 2 + 1]);
                    }
                    *(u32x4*)(merged + (size_t)row * DM + c0 + bj * HALF) = w;
                }
            }
    }
};
struct EpiWout {
    bf16_t* u;
    __device__ __forceinline__ void operator()(const f32x4 (&acc)[2][2][4][2], const Unit& u_, int wr, int wc, int fr, int fq) const {
        const int c0 = u_.pn * BM + wc * 32 + fq * 8;
#pragma unroll
        for (int ai = 0; ai < 2; ++ai)
#pragma unroll
            for (int m = 0; m < 4; ++m) {
                const size_t off = (size_t)(u_.pm * BM + ai * HALF + wr * 64 + m * 16 + fr) * DM + c0;
#pragma unroll
                for (int bj = 0; bj < 2; ++bj) { const f32x4 v0 = acc[ai][bj][m][0], v1 = acc[ai][bj][m][1];
                    u32x4 w; w.x = cvt_pk_bf16(v0[0], v0[1]); w.y = cvt_pk_bf16(v0[2], v0[3]); w.z = cvt_pk_bf16(v1[0], v1[1]); w.w = cvt_pk_bf16(v1[2], v1[3]);
                    *(u32x4*)(u + off + bj * HALF) = w; }
            }
    }
};
struct EpiNull { __device__ __forceinline__ void operator()(const f32x4 (&acc)[2][2][4][2], const Unit& u, int wr, int wc, int fr, int fq) const {
    _Pragma("unroll") for (int a = 0; a < 2; ++a) _Pragma("unroll") for (int b = 0; b < 2; ++b) _Pragma("unroll") for (int m = 0; m < 4; ++m) _Pragma("unroll") for (int n = 0; n < 2; ++n) asm volatile("" :: "v"(acc[a][b][m][n])); } };
__device__ __forceinline__ unsigned f2e4m3(float v) {
    const unsigned s = (__float_as_uint(v) >> 24) & 0x80u;
    const float x = fminf(fabsf(v), 448.f);
    unsigned b = __float_as_uint(x); b += 0x7FFFFu + ((b >> 20) & 1u);
    const unsigned rn = (b >> 20) - 960u;
    const unsigned rs = (unsigned)__builtin_rintf(x * 512.f);
    return s | (x < 0.015625f ? rs : rn);
}
#ifndef SOFT_FP8
#define SOFT_FP8 0
#endif
__device__ __forceinline__ unsigned pk4_fp8(float a, float b, float c, float d) {
    if (SOFT_FP8) return f2e4m3(a) | (f2e4m3(b) << 8) | (f2e4m3(c) << 16) | (f2e4m3(d) << 24);
    int w = 0; w = __builtin_amdgcn_cvt_pk_fp8_f32(a, b, w, false); w = __builtin_amdgcn_cvt_pk_fp8_f32(c, d, w, true); return (unsigned)w; }
template <bool OUT8> struct EpiSwigluT {
    unsigned char* act; const float* bupp; float sc;
    __device__ __forceinline__ void operator()(const f32x4 (&acc)[2][2][4][2], const Unit& u, int wr, int wc, int fr, int fq) const {
        const int pc = wc * 32 + fq * 8, e = u.pb >> 4;
        const float* bp = bupp + e * 4096 + u.pn * 256 + pc;
        f32x4 bg[2], bl[2];
#pragma unroll
        for (int n = 0; n < 2; ++n) { bg[n] = *(const f32x4*)(bp + 4 * n); bl[n] = *(const f32x4*)(bp + HALF + 4 * n); }
#pragma unroll
        for (int ai = 0; ai < 2; ++ai)
#pragma unroll
            for (int m = 0; m < 4; ++m) {
                const int row = u.pm * BM + ai * HALF + wr * 64 + m * 16 + fr;
                float o[8];
#pragma unroll
                for (int n = 0; n < 2; ++n)
#pragma unroll
                    for (int i = 0; i < 4; ++i) {
                        float g = acc[ai][0][m][n][i] * sc + bg[n][i], l = acc[ai][1][m][n][i] * sc + bl[n][i];
                        g = fminf(g, 7.f); l = fminf(fmaxf(l, -7.f), 7.f);
                        o[4 * n + i] = g * sigm_fast(1.702f * g) * (l + 1.f);
                    }
                if constexpr (OUT8) { u32x2 w; w.x = pk4_fp8(o[0], o[1], o[2], o[3]); w.y = pk4_fp8(o[4], o[5], o[6], o[7]);
                    *(u32x2*)(act + (size_t)row * DM + u.pn * HALF + pc) = w; }
                else { u32x4 w; w.x = cvt_pk_bf16(o[0], o[1]); w.y = cvt_pk_bf16(o[2], o[3]); w.z = cvt_pk_bf16(o[4], o[5]); w.w = cvt_pk_bf16(o[6], o[7]);
                    *(u32x4*)((bf16_t*)act + (size_t)row * DM + u.pn * HALF + pc) = w; }
            }
    }
};
constexpr float Y8_SCALE = 16.f;
struct EpiDown {
    unsigned char* y; const float* bdn; const float* roww; float sc;
    __device__ __forceinline__ void operator()(const f32x4 (&acc)[2][2][4][2], const Unit& u, int wr, int wc, int fr, int fq) const {
        const int c0 = u.pn * BM + wc * 32 + fq * 8, e = u.pb >> 3;
        f32x4 bv[2][2];
#pragma unroll
        for (int bj = 0; bj < 2; ++bj)
#pragma unroll
            for (int n = 0; n < 2; ++n) bv[bj][n] = *(const f32x4*)(bdn + e * DM + c0 + bj * HALF + 4 * n);
#pragma unroll
        for (int ai = 0; ai < 2; ++ai)
#pragma unroll
            for (int m = 0; m < 4; ++m) {
                const int row = u.pm * BM + ai * HALF + wr * 64 + m * 16 + fr; const float rw = roww[row] * Y8_SCALE;
#pragma unroll
                for (int bj = 0; bj < 2; ++bj) {
                    const f32x4 v0 = (acc[ai][bj][m][0] * sc + bv[bj][0]) * rw, v1 = (acc[ai][bj][m][1] * sc + bv[bj][1]) * rw;
                    u32x2 w; w.x = pk4_fp8(v0[0], v0[1], v0[2], v0[3]); w.y = pk4_fp8(v1[0], v1[1], v1[2], v1[3]);
                    *(u32x2*)(y + (size_t)row * DM + c0 + bj * HALF) = w;
                }
            }
    }
};
}
#define XB_TMO      128
#define XB_XCNT(j)  (256  + 64 * (j))
#define XB_XSUB(j)  (1280 + 64 * (j))
#define XB_XGEN(j)  (2304 + 64 * (j))
#define XB_TOP      3328
#define XB_TOPGEN   3392
#define XCD_BAR_WORDS 3456
#define XB_SPIN_CAP (1u << 22)

__device__ __forceinline__ unsigned xb_ld(unsigned* p)              { return __hip_atomic_load(p, __ATOMIC_RELAXED, __HIP_MEMORY_SCOPE_AGENT); }
__device__ __forceinline__ unsigned xb_add(unsigned* p, unsigned v) { return __hip_atomic_fetch_add(p, v, __ATOMIC_RELAXED, __HIP_MEMORY_SCOPE_AGENT); }
__device__ __forceinline__ unsigned xb_xcc_id() { return (unsigned)__builtin_amdgcn_s_getreg((3 << 11) | 20) & 0xFu; }
#define XB_SPIN(cond, bar) do { unsigned _sp = 0; while (cond) { __builtin_amdgcn_s_sleep(1); \
    if ((++_sp & 255u) == 0u) { if (xb_ld(&(bar)[XB_TMO])) break; if (_sp > XB_SPIN_CAP) { atomicAdd(&(bar)[XB_TMO], 1u); break; } } } } while (0)

struct XcdBarrier {
    unsigned* bar; unsigned x;
    volatile LAS unsigned* st;
};
__device__ __forceinline__ XcdBarrier xcd_barrier_post(unsigned* bar, volatile LAS unsigned* st) {
    XcdBarrier b; b.bar = bar; b.x = xb_xcc_id(); b.st = st;
    if (threadIdx.x == 0) (void)xb_add(&bar[XB_XCNT(b.x)], 1u);
    return b;
}
__device__ __forceinline__ void xcd_barrier_complete(unsigned* bar, unsigned x, unsigned& nloc, unsigned& nx) {
    const unsigned G = gridDim.x * gridDim.y * gridDim.z;
    unsigned sum, cnt, mine, sp = 0u;
    for (;;) {
        sum = 0u; cnt = 0u; mine = 0u;
#pragma unroll
        for (unsigned j = 0; j < 16; ++j) { const unsigned c = xb_ld(&bar[XB_XCNT(j)]); sum += c; cnt += (c > 0u) ? 1u : 0u; mine = (j == x) ? c : mine; }
        if (sum == G) break;
        __builtin_amdgcn_s_sleep(1);
        if ((++sp & 255u) == 0u) { if (xb_ld(&bar[XB_TMO])) break; if (sp > XB_SPIN_CAP) { atomicAdd(&bar[XB_TMO], 1u); break; } }
    }
    nloc = mine > 0u ? mine : 1u; nx = cnt > 0u ? cnt : 1u;
}
__device__ __forceinline__ void xcd_barrier(const XcdBarrier& b, const bool leader  ) {
    asm volatile("s_waitcnt vmcnt(0)" ::: "memory");
    __syncthreads();
    if (leader) {
        unsigned* bar = b.bar;
        __builtin_amdgcn_s_waitcnt(0);
        unsigned nloc = b.st[0], nx = b.st[1];
        if (nloc == 0u) { xcd_barrier_complete(bar, b.x, nloc, nx); b.st[0] = nloc; b.st[1] = nx; }
        const unsigned old = xb_add(&bar[XB_XSUB(b.x)], 1u);
        const unsigned gen = old / nloc;
        if (old + 1u == (gen + 1u) * nloc) {
            __builtin_amdgcn_fence(__ATOMIC_RELEASE, "agent");
            asm volatile("s_waitcnt vmcnt(0)" ::: "memory");
            const unsigned og = xb_add(&bar[XB_TOP], 1u);
            const unsigned tg = og / nx;
            if (og + 1u == (tg + 1u) * nx) xb_add(&bar[XB_TOPGEN], 1u);
            else XB_SPIN(xb_ld(&bar[XB_TOPGEN]) == tg, bar);
            __builtin_amdgcn_fence(__ATOMIC_ACQUIRE, "agent");
            xb_add(&bar[XB_XGEN(b.x)], 1u);
            asm volatile("s_waitcnt vmcnt(0)" ::: "memory");
        } else {
            XB_SPIN(xb_ld(&bar[XB_XGEN(b.x)]) == gen, bar);
            __builtin_amdgcn_fence(__ATOMIC_ACQUIRE, "agent");
            asm volatile("s_waitcnt vmcnt(0)" ::: "memory");
        }
    }
    __syncthreads();
}
#ifndef PROBE_SUB
#define PROBE_SUB 0
#endif
constexpr int NWAVES = 8;
constexpr int RING_OFF = 0, RING_BYTES = 131072;
constexpr int SCR_WAVE_BYTES = 64 * 65 * 4;
constexpr int LDSCTL_OFF = 139264, MISC_OFF = LDSCTL_OFF + 320;
constexpr int LDS_BYTES = 147456;
static_assert(NWAVES * SCR_WAVE_BYTES <= LDSCTL_OFF && MISC_OFF + 128 <= LDS_BYTES, "LDS map");

struct Frame {
    LAS unsigned char* lds;
    volatile LAS unsigned* MISC;
    unsigned* ctl;
    int tid, lane, wave, vcu, G;
};

template <class ColFn>
__device__ __forceinline__ void transpose_item(const float* W, int ldw, int K, bf16_t* WT, int dst_row0, int k0, ColFn colfn, LAS float* scr, int lane) {
    const int ks = lane >> 4, n4 = lane & 15; const int sc = colfn(n4);
    f32x4 v[16];
#pragma unroll
    for (int i = 0; i < 16; ++i) v[i] = sc >= 0 ? *(const f32x4*)(W + (size_t)(k0 + 4 * i + ks) * ldw + sc) : (f32x4){0.f, 0.f, 0.f, 0.f};
#pragma unroll
    for (int i = 0; i < 16; ++i) {
        *(LAS f32x4*)(scr + (4 * i + ks) * 64 + ((n4 ^ (i >> 1)) << 2)) = v[i];
    }
    asm volatile("s_waitcnt lgkmcnt(0)" ::: "memory");
    const int nsub = lane >> 3, c = lane & 7;
#pragma unroll
    for (int q = 0; q < 8; ++q) {
        const int n = 8 * q + nsub; const LAS float* s = scr + (8 * c) * 64 + (n ^ (c << 2));
        u32x4 o; o.x = cvt_pk_bf16(s[0 * 64], s[1 * 64]); o.y = cvt_pk_bf16(s[2 * 64], s[3 * 64]); o.z = cvt_pk_bf16(s[4 * 64], s[5 * 64]); o.w = cvt_pk_bf16(s[6 * 64], s[7 * 64]);
        *(u32x4*)(WT + (size_t)(dst_row0 + n) * K + k0 + 8 * c) = o;
    }
    asm volatile("s_waitcnt lgkmcnt(0)" ::: "memory");
}

template <class ColFn>
__device__ __forceinline__ void transpose_item8(const float* W, int ldw, int K, unsigned char* WT, int dst_row0, int k0, ColFn colfn, LAS float* scr, int lane, float wscale) {
    const int ks = lane >> 4, n4 = lane & 15; const int sc = colfn(n4);
    f32x4 v[16];
#pragma unroll
    for (int i = 0; i < 16; ++i) v[i] = sc >= 0 ? *(const f32x4*)(W + (size_t)(k0 + 4 * i + ks) * ldw + sc) : (f32x4){0.f, 0.f, 0.f, 0.f};
#pragma unroll
    for (int i = 0; i < 16; ++i) {
        *(LAS f32x4*)(scr + (4 * i + ks) * 64 + ((n4 ^ (i >> 1)) << 2)) = v[i];
    }
    asm volatile("s_waitcnt lgkmcnt(0)" ::: "memory");
    const int nsub = lane >> 3, c = lane & 7;
#pragma unroll
    for (int q = 0; q < 8; ++q) {
        const int n = 8 * q + nsub; const LAS float* s = scr + (8 * c) * 64 + (n ^ (c << 2));
        u32x2 o; o.x = pg8::pk4_fp8(s[0 * 64] * wscale, s[1 * 64] * wscale, s[2 * 64] * wscale, s[3 * 64] * wscale); o.y = pg8::pk4_fp8(s[4 * 64] * wscale, s[5 * 64] * wscale, s[6 * 64] * wscale, s[7 * 64] * wscale);
        *(u32x2*)(WT + (size_t)(dst_row0 + n) * K + k0 + 8 * c) = o;
    }
    asm volatile("s_waitcnt lgkmcnt(0)" ::: "memory");
}
constexpr float W8_SCALE = 64.f;
struct MoeWItem { const float* src; unsigned char* dst; int ldw; };
__device__ __forceinline__ MoeWItem moe_w_decode(const Args& a, int idx, int wv, int lane) {
    unsigned char* ws = a.ws; const int ks = lane >> 4, n4 = lane & 15; MoeWItem it;
    if (idx < 8192) { const int e = idx >> 8, rem = idx & 255, grp = rem & 63, kb = (rem >> 6) * 8 + wv, r0 = grp * 64, pn = r0 >> 8, p0 = r0 & 255;
        const int sc0 = (p0 < 128 ? 128 * pn + p0 : 2048 + 128 * pn + p0 - 128) + 4 * n4;
        it.src = a.in[16] + (size_t)e * DM * 4096 + (size_t)(kb * 64 + ks) * 4096 + sc0; it.ldw = 4096; it.dst = (unsigned char*)(ws + WS_WUP) + (size_t)e * 4096 * DM + (size_t)r0 * DM + kb * 64; }
    else { const int i2 = idx - 8192, e = i2 >> 7, rem = i2 & 127, grp = rem & 31, kb = (rem >> 5) * 8 + wv, r0 = grp * 64;
        it.src = a.in[18] + (size_t)e * DM * DM + (size_t)(kb * 64 + ks) * DM + r0 + 4 * n4; it.ldw = DM; it.dst = (unsigned char*)(ws + WS_WDN) + (size_t)e * DM * DM + (size_t)r0 * DM + kb * 64; }
    return it;
}
__device__ __forceinline__ void moe_w_load(f32x4 (&v)[16], const MoeWItem& it) {
#pragma unroll
    for (int i = 0; i < 16; ++i) v[i] = *(const f32x4*)(it.src + (size_t)(4 * i) * it.ldw);
}
__device__ __forceinline__ void moe_w_to_lds(const f32x4 (&v)[16], LAS float* scr, int lane) {
    const int ks = lane >> 4, n4 = lane & 15;
#pragma unroll
    for (int i = 0; i < 16; ++i) *(LAS f32x4*)(scr + (4 * i + ks) * 64 + ((n4 ^ (i >> 1)) << 2)) = v[i];
    asm volatile("s_waitcnt lgkmcnt(0)" ::: "memory");
}
__device__ __forceinline__ void moe_w_from_lds(const MoeWItem& it, LAS float* scr, int lane) {
    const int nsub = lane >> 3, c = lane & 7;
#pragma unroll
    for (int q = 0; q < 8; ++q) {
        const int n = 8 * q + nsub; const LAS float* s = scr + (8 * c) * 64 + (n ^ (c << 2));
        u32x2 o; o.x = pg8::pk4_fp8(s[0 * 64] * W8_SCALE, s[1 * 64] * W8_SCALE, s[2 * 64] * W8_SCALE, s[3 * 64] * W8_SCALE); o.y = pg8::pk4_fp8(s[4 * 64] * W8_SCALE, s[5 * 64] * W8_SCALE, s[6 * 64] * W8_SCALE, s[7 * 64] * W8_SCALE);
        *(u32x2*)(it.dst + (size_t)n * DM + 8 * c) = o;
    }
    asm volatile("s_waitcnt lgkmcnt(0)" ::: "memory");
}
__device__ __forceinline__ void moe_w_batch(const Args& a, int i0, int i1, LAS float* scr, int wv, int lane) {
    if (i0 >= i1) return;
    f32x4 v[16];
    MoeWItem cur = moe_w_decode(a, i0, wv, lane);
    moe_w_load(v, cur);
#pragma unroll 1
    for (int i = i0; i < i1; ++i) {
        moe_w_to_lds(v, scr, lane);
        MoeWItem nxt = cur;
        if (i + 1 < i1) { nxt = moe_w_decode(a, i + 1, wv, lane); moe_w_load(v, nxt); }
        moe_w_from_lds(cur, scr, lane);
        cur = nxt;
    }
}
constexpr int MOE_W_ITEMS = 8192 + 4096, MOE_W_BATCH = 8;
__device__ __forceinline__ void p0_prologue(Frame& F, const Args& a) {
    unsigned char* ws = a.ws;
    LAS float* scr = (LAS float*)(F.lds + F.wave * SCR_WAVE_BYTES);
    const int gw = F.vcu * NWAVES + F.wave, NGW = F.G * NWAVES, gt = gw * 64 + F.lane, NGT = NGW * 64;
    { float* rc = (float*)(ws + WS_ROPE); float* rs = rc + 4096 * 64;
      for (int i = gt; i < 4096 * 64; i += NGT) { const int t = i >> 6, j = i & 63; const float inv = powf(10000.f, -(float)(2 * j) / 128.f); const float ang = (float)t * inv; float sn, cs; sincosf(ang, &sn, &cs); rc[i] = cs; rs[i] = sn; }
      int* rowtok = (int*)(ws + WS_ROUTE + 4 * 512 * 1024); float* roww = (float*)(ws + WS_ROUTE + 4 * 512 * 1024 + 544 * 1024);
      for (int i = gt; i < MOE_ROWS; i += NGT) { rowtok[i] = 0; roww[i] = 0.f; }
      float* binp = (float*)(ws + WS_BINP); const float* b_in = a.in[2];
      for (int i = gt; i < LDP; i += NGT) { const int pn = i >> 8, wc = wcol_of(pn * 256 + inproj_phys2log(pn, i & 255)); binp[i] = wc >= 0 ? b_in[wc] : 0.f; }
      { const float* wr_ = a.in[14]; bf16_t* wrh = (bf16_t*)(ws + WS_WRT); bf16_t* wrl = wrh + 32 * 2048;
        for (int i = gt; i < 32 * 2048; i += NGT) { const int e = i >> 11, k = i & 2047; const float w = wr_[k * 32 + e]; const unsigned hb_ = cvt_pk_bf16(w, 0.f) & 0xffffu;
            wrh[i] = (bf16_t)hb_; wrl[i] = (bf16_t)(cvt_pk_bf16(w - __uint_as_float(hb_ << 16), 0.f) & 0xffffu); } }
      float* bupp = (float*)(ws + WS_BUPP); const float* b_up = a.in[17];
      for (int i = gt; i < NEXP * 4096; i += NGT) { const int e = i >> 12, n = i & 4095, pn = n >> 8, p = n & 255; bupp[i] = b_up[e * 4096 + (p < 128 ? 128 * pn + p : 2048 + 128 * pn + p - 128)]; }
    }
    if (gw < 128) { const int which = gw >> 6, chunk = (gw >> 2) & 15, n = (gw & 3) * 64 + F.lane; const float* pos = a.in[3 + which] + chunk * 256; const float* w1 = a.in[which ? 7 : 5] + (size_t)chunk * 256 * 256; float acc = 0.f;
#pragma unroll 16
        for (int k = 0; k < 256; ++k) acc += pos[k] * w1[(size_t)k * 256 + n];
        ((float*)(ws + WS_POSB))[(which * 16 + chunk) * 256 + n] = acc; }
    { const float* x = a.in[0]; bf16_t* xb = (bf16_t*)(ws + WS_XB); const float* w_in = a.in[1]; const float* b_in = a.in[2];
      constexpr int GLP = 4112;
      for (int idx = F.tid; idx < 2048 * 8; idx += NWAVES * 64) { const int k = idx >> 3, q = idx & 7;
          f32x4 w = {0.f, 0.f, 0.f, 0.f}; if (q < 6) w = *(const f32x4*)(w_in + (size_t)k * IN_W + 2560 + 4 * q);
#pragma unroll
          for (int i = 0; i < 4; ++i) *(LAS unsigned short*)(F.lds + (4 * q + i) * GLP + k * 2) = (unsigned short)(cvt_pk_bf16(w[i], 0.f) & 0xffffu); }
      __syncthreads();
      const int i = F.lane & 15, kq = F.lane >> 4;
      bf16_t* gl = (bf16_t*)(ws + WS_PROJ + PJ_GL);
      const float bias0 = b_in[2560 + i], bias1 = i < 8 ? b_in[2560 + 16 + i] : 0.f;
      for (int grp = gw; grp < T_ / 16; grp += NGW) {
          const int r0 = grp * 16;
          const float* xr = x + (size_t)(r0 + i) * DM + 4 * kq; bf16_t* xo = xb + (size_t)(r0 + i) * DM + 4 * kq;
          const LAS unsigned char* bp = F.lds + i * GLP + kq * 8;
          f32x4 acc0 = {0.f, 0.f, 0.f, 0.f}, acc1 = {0.f, 0.f, 0.f, 0.f};
#pragma unroll 1
          for (int sb = 0; sb < 64; sb += 8) {
              f32x4 xa[8], xc[8];
#pragma unroll
              for (int u = 0; u < 8; ++u) { xa[u] = *(const f32x4*)(xr + 32 * (sb + u)); xc[u] = *(const f32x4*)(xr + 32 * (sb + u) + 16); }
#pragma unroll
              for (int u = 0; u < 8; ++u) { const int s2 = sb + u;
                  u32x4 pk; pk.x = cvt_pk_bf16(xa[u][0], xa[u][1]); pk.y = cvt_pk_bf16(xa[u][2], xa[u][3]); pk.z = cvt_pk_bf16(xc[u][0], xc[u][1]); pk.w = cvt_pk_bf16(xc[u][2], xc[u][3]);
                  { u32x2 lo_; lo_.x = pk.x; lo_.y = pk.y; u32x2 hi_; hi_.x = pk.z; hi_.y = pk.w; *(u32x2*)(xo + 32 * s2) = lo_; *(u32x2*)(xo + 32 * s2 + 16) = hi_; }
                  u32x4 b0, b1; { const u32x2 p0 = *(const LAS u32x2*)(bp + s2 * 64), p1 = *(const LAS u32x2*)(bp + s2 * 64 + 32), q0 = *(const LAS u32x2*)(bp + 16 * GLP + s2 * 64), q1 = *(const LAS u32x2*)(bp + 16 * GLP + s2 * 64 + 32); b0.x = p0.x; b0.y = p0.y; b0.z = p1.x; b0.w = p1.y; b1.x = q0.x; b1.y = q0.y; b1.z = q1.x; b1.w = q1.y; }
                  acc0 = __builtin_amdgcn_mfma_f32_16x16x32_bf16(__builtin_bit_cast(bf16x8, pk), __builtin_bit_cast(bf16x8, b0), acc0, 0, 0, 0);
                  acc1 = __builtin_amdgcn_mfma_f32_16x16x32_bf16(__builtin_bit_cast(bf16x8, pk), __builtin_bit_cast(bf16x8, b1), acc1, 0, 0, 0); }
          }
#pragma unroll
          for (int r = 0; r < 4; ++r) { const size_t tok = (size_t)(r0 + 4 * kq + r);
              gl[tok * 32 + i] = (bf16_t)(cvt_pk_bf16(sigm_fast(acc0[r] + bias0), 0.f) & 0xffffu);
              gl[tok * 32 + 16 + i] = (bf16_t)(cvt_pk_bf16(sigm_fast(acc1[r] + bias1), 0.f) & 0xffffu); }
      }
      __syncthreads();
    }
    const int wg = F.vcu, NWG = F.G, wv = F.wave;
#define TR_LOOP8(nmat, ngrp, nk, W_OF, LDW, KK, WT_OF, ROW0_OF, COLFN) \
    for (int wi = wg; wi < (nmat) * (ngrp) * (((nk) + 7) / 8); wi += NWG) { \
        const int per = (ngrp) * (((nk) + 7) / 8), e = wi / per, rem = wi - e * per, grp = rem % (ngrp), kb = (rem / (ngrp)) * 8 + wv; \
        if (kb < (nk)) { const int r0 = (ROW0_OF); transpose_item8((W_OF), (LDW), (KK), (WT_OF), r0, kb * 64, COLFN, scr, F.lane, W8_SCALE); } }
#define TR_LOOP(OFF, nmat, ngrp, nk, W_OF, LDW, KK, WT_OF, ROW0_OF, COLFN) \
    for (int wi = (wg + NWG - ((OFF) % NWG)) % NWG; wi < (nmat) * (ngrp) * (((nk) + 7) / 8); wi += NWG) {        \
        const int per = (ngrp) * (((nk) + 7) / 8), e = wi / per, rem = wi - e * per, grp = rem % (ngrp), kb = (rem / (ngrp)) * 8 + wv; \
        if (kb < (nk)) { const int r0 = (ROW0_OF); transpose_item((W_OF), (LDW), (KK), (WT_OF), r0, kb * 64, COLFN, scr, F.lane); } }
    TR_LOOP(0, 1, 176, 32, a.in[1], IN_W, DM, (bf16_t*)(ws + WS_WIN), grp * 64, ([&](int n4) { const int pn = r0 >> 8; return wcol_of(pn * 256 + inproj_phys2log(pn, (r0 & 255) + 4 * n4)); }))
    TR_LOOP(704, 1, 32, 16, a.in[9], DM, 1024, (bf16_t*)(ws + WS_WBA), grp * 64, ([&](int n4) { return r0 + 4 * n4; }))
    TR_LOOP(768, 1, 32, 8, a.in[10], DM, 512, (bf16_t*)(ws + WS_WBD), grp * 64, ([&](int n4) { return r0 + 4 * n4; }))
    TR_LOOP(800, 1, 32, 32, a.in[11], DM, DM, (bf16_t*)(ws + WS_WOUT), grp * 64, ([&](int n4) { return r0 + 4 * n4; }))
    TR_LOOP(928, 2, 4, 64, a.in[e ? 7 : 5], 256, 4096, (bf16_t*)(ws + WS_CW1) + (size_t)e * 256 * 4096, grp * 64, ([&](int n4) { return r0 + 4 * n4; }))
    TR_LOOP(992, 2, 2, 4, a.in[e ? 8 : 6], 128, 256, (bf16_t*)(ws + WS_CW2) + (size_t)e * 128 * 256, grp * 64, ([&](int n4) { return r0 + 4 * n4; }))
#undef TR_LOOP
#undef TR_LOOP8
}
__device__ __forceinline__ void p_ln1_router(Frame& F, const Args& a) {
    unsigned char* ws = a.ws;
    const float* g = a.in[12]; const float* bb = a.in[13]; const float* wr = a.in[14]; const float* br = a.in[15];
    unsigned* ctl = F.ctl;
    int* topi = (int*)(ws + WS_ROUTE); float* topw = (float*)(ws + WS_ROUTE + 512 * 1024); int* pos = (int*)(ws + WS_ROUTE + 2 * 512 * 1024);
    const int gw = F.vcu * NWAVES + F.wave, NGW = F.G * NWAVES, lane = F.lane;
    LAS float* lt = (LAS float*)(F.lds) + F.wave * (16 * 33);
    const bool agg = ((T_ / 16) % NGW) == 0;
    LAS unsigned* lcnt = (LAS unsigned*)(F.lds + 20480); LAS unsigned* lbase = lcnt + 32;
    if (agg) { if (F.tid < 32) lcnt[F.tid] = 0u; __syncthreads(); }
    for (int grp = gw; grp < T_ / 16; grp += NGW) {
        const int tok0 = grp * 16;
        const float* x = a.in[0]; const bf16_t* ub = (const bf16_t*)(ws + WS_Z);
        f32x4 xn[8]; u32x4 un[4];
#pragma unroll
        for (int j = 0; j < 4; ++j) { const size_t o = (size_t)tok0 * DM + (lane + 64 * j) * 8; xn[2 * j] = *(const f32x4*)(x + o); xn[2 * j + 1] = *(const f32x4*)(x + o + 4); un[j] = *(const u32x4*)(ub + o); }
#pragma unroll 1
        for (int ti = 0; ti < 16; ++ti) {
            const int tok = tok0 + ti;
            bf16_t* hh = (bf16_t*)(ws + WS_H) + (size_t)tok * DM; bf16_t* hl = hh + (size_t)T_ * DM; unsigned char* hb = (unsigned char*)(ws + WS_HB) + (size_t)tok * DM;
            float v[32]; float s = 0.f;
#pragma unroll
            for (int j = 0; j < 4; ++j)
#pragma unroll
                for (int i = 0; i < 8; ++i) { const unsigned w = un[j][i >> 1]; const float uu = __uint_as_float((i & 1) ? (w & 0xffff0000u) : (w << 16)); const float t = DN_ALPHA * xn[2 * j + (i >> 2)][i & 3] + uu; v[8 * j + i] = t; s += t; }
            { const size_t o1 = (size_t)(tok + (ti < 15 ? 1 : 0)) * DM;
#pragma unroll
              for (int j = 0; j < 4; ++j) { const size_t o = o1 + (lane + 64 * j) * 8; xn[2 * j] = *(const f32x4*)(x + o); xn[2 * j + 1] = *(const f32x4*)(x + o + 4); un[j] = *(const u32x4*)(ub + o); } }
            const float mean = wave_sum(s) * (1.f / DM); float q = 0.f;
#pragma unroll
            for (int i = 0; i < 32; ++i) { v[i] -= mean; q += v[i] * v[i]; }
            const float rstd = rsqrtf(wave_sum(q) * (1.f / DM) + LN_EPS);
#pragma unroll
            for (int j = 0; j < 4; ++j) {
                const int k0 = (lane + 64 * j) * 8;
                float hv[8];
#pragma unroll
                for (int hlf = 0; hlf < 2; ++hlf) { const f32x4 gv = *(const f32x4*)(g + k0 + 4 * hlf), bv = *(const f32x4*)(bb + k0 + 4 * hlf);
#pragma unroll
                    for (int i = 0; i < 4; ++i) hv[4 * hlf + i] = v[8 * j + 4 * hlf + i] * rstd * gv[i] + bv[i]; }
                { u32x4 wh, wl;
#pragma unroll
                  for (int i = 0; i < 4; ++i) { const unsigned ph = cvt_pk_bf16(hv[2 * i], hv[2 * i + 1]); wh[i] = ph;
                      wl[i] = cvt_pk_bf16(hv[2 * i] - __uint_as_float(ph << 16), hv[2 * i + 1] - __uint_as_float(ph & 0xffff0000u)); }
                  *(u32x4*)(hh + k0) = wh; *(u32x4*)(hl + k0) = wl; }
                u32x2 w8; w8.x = pg8::pk4_fp8(hv[0], hv[1], hv[2], hv[3]); w8.y = pg8::pk4_fp8(hv[4], hv[5], hv[6], hv[7]);
                *(u32x2*)(hb + k0) = w8;
            }
        }
        asm volatile("s_waitcnt vmcnt(0)" ::: "memory");
        { const int i = lane & 15, kq = lane >> 4;
          const bf16_t* ah = (const bf16_t*)(ws + WS_H) + (size_t)(tok0 + i) * DM + kq * 8; const bf16_t* al = ah + (size_t)T_ * DM;
          const bf16_t* bh0 = (const bf16_t*)(ws + WS_WRT) + (size_t)i * 2048 + kq * 8; const bf16_t* bl0 = bh0 + 32 * 2048;
          f32x4 acc0 = {0.f, 0.f, 0.f, 0.f}, acc1 = {0.f, 0.f, 0.f, 0.f};
#pragma unroll 4
          for (int s2 = 0; s2 < 64; ++s2) {
              const bf16x8 xh = *(const bf16x8*)(ah + 32 * s2), xl = *(const bf16x8*)(al + 32 * s2);
              const bf16x8 wh0 = *(const bf16x8*)(bh0 + 32 * s2), wl0 = *(const bf16x8*)(bl0 + 32 * s2), wh1 = *(const bf16x8*)(bh0 + 16 * 2048 + 32 * s2), wl1 = *(const bf16x8*)(bl0 + 16 * 2048 + 32 * s2);
              acc0 = __builtin_amdgcn_mfma_f32_16x16x32_bf16(xh, wl0, acc0, 0, 0, 0); acc0 = __builtin_amdgcn_mfma_f32_16x16x32_bf16(xl, wh0, acc0, 0, 0, 0); acc0 = __builtin_amdgcn_mfma_f32_16x16x32_bf16(xh, wh0, acc0, 0, 0, 0);
              acc1 = __builtin_amdgcn_mfma_f32_16x16x32_bf16(xh, wl1, acc1, 0, 0, 0); acc1 = __builtin_amdgcn_mfma_f32_16x16x32_bf16(xl, wh1, acc1, 0, 0, 0); acc1 = __builtin_amdgcn_mfma_f32_16x16x32_bf16(xh, wh1, acc1, 0, 0, 0);
          }
#pragma unroll
          for (int r = 0; r < 4; ++r) { lt[(4 * kq + r) * 33 + i] = acc0[r]; lt[(4 * kq + r) * 33 + 16 + i] = acc1[r]; }
        }
        asm volatile("s_waitcnt lgkmcnt(0)" ::: "memory");
        int idx[4] = {0, 0, 0, 0}; unsigned lp[4] = {0u, 0u, 0u, 0u};
        if (lane < 16) {
            const int tok = tok0 + lane;
            float lg[32];
#pragma unroll
            for (int e = 0; e < 32; ++e) lg[e] = lt[lane * 33 + e] + br[e];
            float val[4];
#pragma unroll
            for (int k = 0; k < 4; ++k) { float best = -INFINITY; int bi = 0;
#pragma unroll
                for (int e = 0; e < 32; ++e) { bool taken = false;
#pragma unroll
                    for (int kk = 0; kk < k; ++kk) taken |= (idx[kk] == e);
                    if (!taken && lg[e] > best) { best = lg[e]; bi = e; } }
                idx[k] = bi; val[k] = best; }
            const float e1 = expf(val[1] - val[0]), e2 = expf(val[2] - val[0]), e3 = expf(val[3] - val[0]), den = 1.f + e1 + e2 + e3;
            const float w4[4] = {1.f / den, e1 / den, e2 / den, e3 / den};
#pragma unroll
            for (int k = 0; k < 4; ++k) { const int e = idx[k]; topi[tok * 4 + k] = e; topw[tok * 4 + k] = w4[k];
                if (agg) lp[k] = __hip_atomic_fetch_add(lcnt + e, 1u, __ATOMIC_RELAXED, __HIP_MEMORY_SCOPE_WORKGROUP);
                else pos[tok * 4 + k] = (int)atomicAdd(&ctl[CW_CNT + e], 1u); }
        }
        if (agg) {
            __syncthreads();
            if (F.tid < 32) { const unsigned c_ = lcnt[F.tid]; lbase[F.tid] = c_ ? atomicAdd(&ctl[CW_CNT + F.tid], c_) : 0u; lcnt[F.tid] = 0u; }
            __syncthreads();
            if (lane < 16) { const int tok = tok0 + lane;
#pragma unroll
                for (int k = 0; k < 4; ++k) pos[tok * 4 + k] = (int)(lbase[idx[k]] + lp[k]); }
            __syncthreads();
        }
        asm volatile("s_waitcnt lgkmcnt(0)" ::: "memory");
    }
}
__device__ __forceinline__ void p_scatter(Frame& F, const Args& a) {
    unsigned char* ws = a.ws; unsigned* ctl = F.ctl;
    LAS unsigned* pst = (LAS unsigned*)(F.lds);
    if (F.tid == 0) { unsigned acc = 0; for (int e = 0; e < 32; ++e) { pst[e] = acc; acc += ((ctl[CW_CNT + e] + 255u) >> 8) << 8; } pst[32] = acc; }
    __syncthreads();
    if (blockIdx.x == 0) {
        if (F.tid < 32) { const unsigned s0 = pst[F.tid] >> 8, s1 = pst[F.tid + 1] >> 8; for (unsigned t = s0; t < s1; ++t) ctl[CW_TILEEXP + t] = (unsigned)F.tid; }
        if (F.tid == 0) ctl[CW_NTILES] = pst[32] >> 8;
    }
    const int* topi = (const int*)(ws + WS_ROUTE); const float* topw = (const float*)(ws + WS_ROUTE + 512 * 1024); const int* pos = (const int*)(ws + WS_ROUTE + 2 * 512 * 1024);
    int* dest = (int*)(ws + WS_ROUTE + 3 * 512 * 1024);
    int* rowtok = (int*)(ws + WS_ROUTE + 4 * 512 * 1024); float* roww = (float*)(ws + WS_ROUTE + 4 * 512 * 1024 + 544 * 1024);
    for (int i = blockIdx.x * (NWAVES * 64) + F.tid; i < T_ * 4; i += F.G * NWAVES * 64) { const int d = (int)pst[topi[i]] + pos[i]; dest[i] = d; rowtok[d] = i >> 2; roww[d] = topw[i]; }
    __syncthreads();
}
__device__ __forceinline__ void p_final(Frame& F, const Args& a) {
    unsigned char* ws = a.ws;
    const unsigned char* y = (const unsigned char*)(ws + WS_Y);
    typedef int i32x4 __attribute__((ext_vector_type(4)));
    const i32x4* dest4 = (const i32x4*)(ws + WS_ROUTE + 3 * 512 * 1024);
    const float* g = a.in[20]; const float* bb = a.in[21];
    const int gw = F.vcu * NWAVES + F.wave, NGW = F.G * NWAVES, lane = F.lane;
    LAS unsigned char* buf = F.lds + F.wave * 16384;
#define FIN_DMA(tok_, dk_) do { const unsigned char* hs_ = (const unsigned char*)(ws + WS_H) + (size_t)(tok_) * (DM * 2) + lane * 16;        \
        _Pragma("unroll") for (int q = 0; q < 4; ++q) __builtin_amdgcn_global_load_lds((const unsigned*)(hs_ + q * 1024), (LAS unsigned*)(buf + q * 1024), 16, 0, 0); \
        _Pragma("unroll") for (int k = 0; k < 4; ++k) { const unsigned char* ys_ = y + (size_t)dk_[k] * DM + lane * 16; \
            _Pragma("unroll") for (int q = 0; q < 2; ++q) __builtin_amdgcn_global_load_lds((const unsigned*)(ys_ + q * 1024), (LAS unsigned*)(buf + 8192 + k * 2048 + q * 1024), 16, 0, 0); } } while (0)
    int tok = gw; if (tok >= T_) return;
    f32x4 GV[8], BV[8];
#pragma unroll
    for (int j = 0; j < 4; ++j)
#pragma unroll
        for (int hlf = 0; hlf < 2; ++hlf) { GV[2 * j + hlf] = *(const f32x4*)(g + (lane + 64 * j) * 8 + 4 * hlf); BV[2 * j + hlf] = *(const f32x4*)(bb + (lane + 64 * j) * 8 + 4 * hlf); }
#pragma unroll
    for (int j = 0; j < 8; ++j) asm volatile("" : "+v"(GV[j]), "+v"(BV[j]));
    i32x4 d1 = dest4[tok + NGW < T_ ? tok + NGW : tok];
    { const i32x4 d0 = dest4[tok]; FIN_DMA(tok, d0); }
    asm volatile("s_waitcnt vmcnt(0)" ::: "memory");
#pragma unroll 1
    for (;;) {
        const int tok1 = tok + NGW, tok2 = tok + 2 * NGW;
        u32x4 H[4]; u32x2 Y[16];
#pragma unroll
        for (int j = 0; j < 4; ++j) { H[j] = *(const LAS u32x4*)(buf + (lane + 64 * j) * 16);
#pragma unroll
            for (int k = 0; k < 4; ++k) Y[4 * j + k] = *(const LAS u32x2*)(buf + 8192 + k * 2048 + (lane + 64 * j) * 8); }
        asm volatile("s_waitcnt lgkmcnt(0)" ::: "memory");
        const i32x4 d2 = dest4[tok2 < T_ ? tok2 : tok];
        if (tok1 < T_) FIN_DMA(tok1, d1);
        float v[32]; float s = 0.f;
#pragma unroll
        for (int j = 0; j < 4; ++j) { float f[8] = {0.f, 0.f, 0.f, 0.f, 0.f, 0.f, 0.f, 0.f};
#pragma unroll
            for (int k = 0; k < 4; ++k)
#pragma unroll
                for (int i = 0; i < 2; ++i) { const auto lo = __builtin_amdgcn_cvt_pk_f32_fp8((int)Y[4 * j + k][i], false), hi2 = __builtin_amdgcn_cvt_pk_f32_fp8((int)Y[4 * j + k][i], true);
                    f[4 * i] += lo[0]; f[4 * i + 1] += lo[1]; f[4 * i + 2] += hi2[0]; f[4 * i + 3] += hi2[1]; }
#pragma unroll
            for (int i = 0; i < 8; ++i) { const unsigned hw_ = H[j][i >> 1]; const float hv_ = __uint_as_float((i & 1) ? (hw_ & 0xffff0000u) : (hw_ << 16));
                const float t = DN_ALPHA * hv_ + f[i] * (1.f / pg8::Y8_SCALE); v[8 * j + i] = t; s += t; } }
        const float mean = wave_sum(s) * (1.f / DM); float q2 = 0.f;
#pragma unroll
        for (int i = 0; i < 32; ++i) { v[i] -= mean; q2 += v[i] * v[i]; }
        const float rstd = rsqrtf(wave_sum(q2) * (1.f / DM) + LN_EPS);
#pragma unroll
        for (int j = 0; j < 4; ++j) { const int c = (lane + 64 * j) * 8;
#pragma unroll
            for (int hlf = 0; hlf < 2; ++hlf) { const f32x4 gv = GV[2 * j + hlf], bv = BV[2 * j + hlf]; f32x4 o;
#pragma unroll
                for (int i = 0; i < 4; ++i) o[i] = v[8 * j + 4 * hlf + i] * rstd * gv[i] + bv[i];
                *(f32x4*)(a.out + (size_t)tok * DM + c + 4 * hlf) = o; } }
        if (tok1 >= T_) break;
        asm volatile("s_waitcnt vmcnt(8)" ::: "memory");
        tok = tok1; d1 = d2;
    }
    asm volatile("s_waitcnt vmcnt(0)" ::: "memory");
#undef FIN_DMA
}
namespace fa {
typedef short s16x4 __attribute__((ext_vector_type(4)));
constexpr int SHM_V = 16384, SHM_K = 16384;
constexpr int L_V = 0, L_K = 2 * SHM_V, L_WS = L_K + 2 * SHM_K, L_IMP = L_WS + 2048, L_SELM = L_IMP + 65536, L_MISC = L_SELM + 512, L_END = L_MISC + 64;
static_assert(L_END <= LDSCTL_OFF, "attention LDS map");
constexpr int kb_off(int b) { return b < 2 ? L_K + b * SHM_K : L_IMP; }
constexpr int vb_off(int b) { return b < 2 ? L_V + b * SHM_V : L_IMP + SHM_K; }
constexpr float SCALE = ATT_SCALE, C2 = 1.4426950408889634f * ATT_SCALE, THR = 8.f;
#define KSWZ(row, colB) ((row) * 256 + ((colB) ^ (((row) & 7) << 4)))
#define SBAR() __builtin_amdgcn_sched_barrier(0)
__device__ __forceinline__ int v_st(int k, int c) { const int kk = (k & ~0xC) | ((k & 4) << 1) | ((k & 8) >> 1); return ((kk >> 3) * 4 + (c >> 5)) * 512 + ((kk & 7) * 32 + (c & 31)) * 2; }
__device__ __forceinline__ int v_rd_base(int lane) { return ((lane & 3) << 3) | (((lane >> 2) & 3) << 6) | (((lane >> 4) & 1) << 5) | (((lane >> 5) & 1) << 8); }
constexpr int v_rd_off(int d0, int ks, int half) { return d0 * 512 + ks * 4096 + half * 2048; }
__device__ __forceinline__ int crow(int r, int hi) { return (r & 3) + 8 * (r >> 2) + 4 * hi; }
__device__ __forceinline__ unsigned cvtpk(float lo, float hi) { unsigned r; asm volatile("v_cvt_pk_bf16_f32 %0, %1, %2" : "=v"(r) : "v"(lo), "v"(hi)); return r; }

__device__ __forceinline__ void mask_tile(f32x16& p0, f32x16& p1, int dq, unsigned W) {
    const float NEG = -__builtin_inff();
#pragma unroll
    for (int r = 0; r < 16; ++r) {
        const int c = (r & 3) + 8 * (r >> 2);
        if ((unsigned)(dq - c) >= W) p0[r] = NEG;
        if ((unsigned)(dq - c - 32) >= W) p1[r] = NEG;
    }
}
__device__ __forceinline__ void partialSM(f32x16& p0, f32x16& p1, float& m_reg, float& mn, float& alpha) {
    float pmax = p0[0];
#pragma unroll
    for (int r = 1; r < 16; ++r) pmax = fmaxf(pmax, p0[r]);
#pragma unroll
    for (int r = 0; r < 16; ++r) pmax = fmaxf(pmax, p1[r]);
    { auto rr = __builtin_amdgcn_permlane32_swap(__float_as_uint(pmax), __float_as_uint(pmax), false, false);
      pmax = fmaxf(__uint_as_float(rr[0]), __uint_as_float(rr[1])); }
    if (__builtin_expect(__all((pmax - m_reg) * SCALE <= THR), 1)) { mn = m_reg; alpha = 1.f; }
    else { mn = fmaxf(m_reg, pmax); alpha = __builtin_amdgcn_exp2f((m_reg - mn) * C2); m_reg = mn; }
    const float mnL = -mn * C2;
#pragma unroll
    for (int r = 0; r < 16; ++r) p0[r] = fmaf(p0[r], C2, mnL);
#pragma unroll
    for (int r = 0; r < 16; ++r) p1[r] = fmaf(p1[r], C2, mnL);
#pragma unroll
    for (int r = 0; r < 16; ++r) p0[r] = __builtin_amdgcn_exp2f(p0[r]);
}
__device__ __forceinline__ void finishSM(f32x16& p0, f32x16& p1, float alpha, float& l_reg, bf16x8& pa0, bf16x8& pa1, bf16x8& pa2, bf16x8& pa3) {
#pragma unroll
    for (int r = 0; r < 16; ++r) p1[r] = __builtin_amdgcn_exp2f(p1[r]);
    float ps = 0;
#pragma unroll
    for (int r = 0; r < 16; ++r) ps += p0[r];
#pragma unroll
    for (int r = 0; r < 16; ++r) ps += p1[r];
    { auto rr = __builtin_amdgcn_permlane32_swap(__float_as_uint(ps), __float_as_uint(ps), false, false);
      ps = __uint_as_float(rr[0]) + __uint_as_float(rr[1]); }
    l_reg = l_reg * alpha + ps;
#define PK4(P, B_, OUT) do { unsigned a0 = cvtpk(P[B_+0], P[B_+1]), a1 = cvtpk(P[B_+2], P[B_+3]);                          \
        unsigned b0 = cvtpk(P[B_+4], P[B_+5]), b1 = cvtpk(P[B_+6], P[B_+7]);                                             \
        auto r0 = __builtin_amdgcn_permlane32_swap(a0, b0, false, false); auto r1 = __builtin_amdgcn_permlane32_swap(a1, b1, false, false); \
        u32x4 w = {r0[0], r1[0], r0[1], r1[1]}; OUT = *reinterpret_cast<bf16x8*>(&w); } while (0)
    PK4(p0, 0, pa0); PK4(p0, 8, pa1); PK4(p1, 0, pa2); PK4(p1, 8, pa3);
#undef PK4
}
template <int KB>
__device__ __forceinline__ void qkt(f32x16& p0, f32x16& p1, const char* K_lds, int r32, int hi, const bf16x8* qr, const float init = 0.f) {
#pragma unroll
    for (int r = 0; r < 16; ++r) { p0[r] = init; p1[r] = init; }
    const char* kb[4];
#pragma unroll
    for (int dd = 0; dd < 4; ++dd) kb[dd] = K_lds + kb_off(KB) + KSWZ(r32, (dd * 16 + hi * 8) * 2);
#pragma unroll
    for (int d0 = 0; d0 < 8; ++d0) { const char* a = kb[d0 & 3] + (d0 >> 2) * 128;
        bf16x8 b0 = *reinterpret_cast<const bf16x8*>(a);
        bf16x8 b1 = *reinterpret_cast<const bf16x8*>(a + 32 * 256);
        p0 = __builtin_amdgcn_mfma_f32_32x32x16_bf16(b0, qr[d0], p0, 0, 0, 0);
        p1 = __builtin_amdgcn_mfma_f32_32x32x16_bf16(b1, qr[d0], p1, 0, 0, 0);
        if (d0 == 3) SBAR(); }
}
template <int VB>
__device__ __forceinline__ void pv_tile(f32x16* o, int vb0_, int vb2_, bf16x8 pa0, bf16x8 pa1, bf16x8 pa2, bf16x8 pa3) {
    const int vb0 = VB == 2 ? vb2_ : vb0_;
#define TRRD(dst, off) asm volatile("ds_read_b64_tr_b16 %0, %1 offset:%2" : "=&v"(dst) : "v"(vb0), "i"(off) : "memory")
#define PV_D0(d0) do { s16x4 l0, l1, l2, l3, h0, h1, h2, h3; constexpr int b_ = (VB < 2 ? VB * SHM_V : 0) + v_rd_off(d0, 0, 0); \
        TRRD(l0, b_); TRRD(h0, b_ + 2048); TRRD(l1, b_ + 4096); TRRD(h1, b_ + 6144); TRRD(l2, b_ + 8192); TRRD(h2, b_ + 10240); TRRD(l3, b_ + 12288); TRRD(h3, b_ + 14336); \
        asm volatile("s_waitcnt lgkmcnt(0)" ::: "memory"); SBAR(); \
        o[d0] = __builtin_amdgcn_mfma_f32_32x32x16_bf16(pa0, (bf16x8){l0[0], l0[1], l0[2], l0[3], h0[0], h0[1], h0[2], h0[3]}, o[d0], 0, 0, 0);   \
        o[d0] = __builtin_amdgcn_mfma_f32_32x32x16_bf16(pa1, (bf16x8){l1[0], l1[1], l1[2], l1[3], h1[0], h1[1], h1[2], h1[3]}, o[d0], 0, 0, 0);   \
        o[d0] = __builtin_amdgcn_mfma_f32_32x32x16_bf16(pa2, (bf16x8){l2[0], l2[1], l2[2], l2[3], h2[0], h2[1], h2[2], h2[3]}, o[d0], 0, 0, 0);   \
        o[d0] = __builtin_amdgcn_mfma_f32_32x32x16_bf16(pa3, (bf16x8){l3[0], l3[1], l3[2], l3[3], h3[0], h3[1], h3[2], h3[3]}, o[d0], 0, 0, 0); } while (0)
    PV_D0(0); PV_D0(1); PV_D0(2); PV_D0(3);
#undef PV_D0
#undef TRRD
}

struct KVSrc { const bf16_t* k; const bf16_t* v; int ld; int tstride; int toff; };
struct DmaOff { unsigned k[2], v[2]; };
__device__ __forceinline__ void dma_offsets(DmaOff& d, const KVSrc& s, int wid, int lane) {
    const unsigned rs = (unsigned)(s.tstride * s.ld * 2);
#pragma unroll
    for (int i = 0; i < 2; ++i) {
        const int ci = 2 * wid + i, row = 4 * ci + (lane >> 4), colB = ((lane & 15) * 16) ^ ((row & 7) << 4);
        d.k[i] = (unsigned)row * rs + (unsigned)colB;
        const int kk = (ci >> 1) * 8 + ((lane & 31) >> 2), k = (kk & ~0xC) | ((kk & 4) << 1) | ((kk & 8) >> 1), c = (2 * (ci & 1) + (lane >> 5)) * 32 + (lane & 3) * 8;
        d.v[i] = (unsigned)k * rs + (unsigned)c * 2u;
    }
}
template <int BF> __device__ __forceinline__ void dma_issue(const DmaOff& d, const KVSrc& s, int kb, LAS unsigned char* ldsl, int wid) {
    const size_t tb = (size_t)(kb * s.tstride + s.toff) * s.ld * 2;
    const char* kt = (const char*)s.k + tb; const char* vt = (const char*)s.v + tb;
#pragma unroll
    for (int i = 0; i < 2; ++i) {
        __builtin_amdgcn_global_load_lds((const unsigned*)(kt + d.k[i]), (LAS unsigned*)(ldsl + kb_off(BF) + (2 * wid + i) * 1024), 16, 0, 0);
        __builtin_amdgcn_global_load_lds((const unsigned*)(vt + d.v[i]), (LAS unsigned*)(ldsl + vb_off(BF) + (2 * wid + i) * 1024), 16, 0, 0);
    }
}

enum { MODE_BAND = 0, MODE_SEL = 1, MODE_STATS = 2, MODE_IMP = 3 };
template <int MODE>
__device__ __forceinline__ void branch_prefetch(char* lds, const KVSrc& src, int j_lo, int j_hi, unsigned long long tmask, const int wid) {
    const int lane = tid_of(wid) & 63;
    LAS unsigned char* ldsl = (LAS unsigned char*)(unsigned)(uintptr_t)lds;
    DmaOff dof; dma_offsets(dof, src, wid, lane);
    auto next_tile = [&](int j) -> int { if (MODE == MODE_SEL) { while (j < j_hi && !((tmask >> j) & 1ull)) ++j; } return j; };
    const int j = next_tile(j_lo);
    if (j >= j_hi) return;
    dma_issue<0>(dof, src, j * 64, ldsl, wid);
    if constexpr (MODE == MODE_BAND || MODE == MODE_SEL) { const int jnx = next_tile(j + 1); if (jnx < j_hi) dma_issue<1>(dof, src, jnx * 64, ldsl, wid); }
}
template <int MODE, bool PREF = false>
__device__ __forceinline__ void run_branch(char* lds, const bf16x8* qr, const KVSrc& src, int j_lo, int j_hi, unsigned long long tmask,
                                           int qidx, int qlo_wave, unsigned W, unsigned long long own, f32x16* o, float& m_reg, float& l_reg,
                                           int imp_row  , const int wid) {
    const int tid = tid_of(wid), lane = tid & 63, r32 = lane & 31, hi = lane >> 5;
    LAS unsigned char* ldsl = (LAS unsigned char*)(unsigned)(uintptr_t)lds;
    const int vb0 = (int)(uintptr_t)(lds + L_V) + v_rd_base(lane), vb2 = (int)(uintptr_t)(lds + vb_off(2)) + v_rd_base(lane);
    float* wsf = (float*)(lds + L_WS) + wid * 64;
    const char* K_lds = lds;
    DmaOff dof; dma_offsets(dof, src, wid, lane);
    auto next_tile = [&](int j) -> int { if (MODE == MODE_SEL) { while (j < j_hi && !((tmask >> j) & 1ull)) ++j; } return j; };
    int j = next_tile(j_lo);
    if (j >= j_hi) { __syncthreads(); return; }
    constexpr bool RING = (MODE == MODE_BAND || MODE == MODE_SEL);
    int jnx = j_hi;
    if constexpr (PREF) { if constexpr (RING) jnx = next_tile(j + 1); asm volatile("s_waitcnt vmcnt(0)" ::: "memory"); }
    else {
        dma_issue<0>(dof, src, j * 64, ldsl, wid);
        if constexpr (RING) { jnx = next_tile(j + 1); if (jnx < j_hi) { dma_issue<1>(dof, src, jnx * 64, ldsl, wid); asm volatile("s_waitcnt vmcnt(4)" ::: "memory"); } else asm volatile("s_waitcnt vmcnt(0)" ::: "memory"); }
        else asm volatile("s_waitcnt vmcnt(0)" ::: "memory");
    }
    __syncthreads();
    float carry = 0.f;
    const float rl = (MODE == MODE_IMP) ? (l_reg > 0.f ? 1.f / l_reg : 0.f) : 0.f;
#define FA_STEP(KB) { \
        int jn; bool more; bool issued_ = false; \
        if constexpr (RING) { jn = jnx; more = jn < j_hi; const int j2_ = more ? next_tile(jn + 1) : j_hi; issued_ = j2_ < j_hi; if (issued_) dma_issue<(KB + 2) % 3>(dof, src, j2_ * 64, ldsl, wid); jnx = j2_; } \
        else { jn = next_tile(j + 1); more = jn < j_hi; if (more) dma_issue<1 - (KB & 1)>(dof, src, jn * 64, ldsl, wid); } \
        SBAR(); \
        f32x16 p0, p1; \
        const int kb_ = j * 64; \
        const bool act = (MODE != MODE_BAND) || (kb_ <= qlo_wave + 31 && kb_ + 63 + (int)W > qlo_wave); \
        if (act) { \
            qkt<KB>(p0, p1, K_lds, r32, hi, qr, (MODE == MODE_SEL && !((own >> j) & 1ull)) ? -__builtin_inff() : 0.f);     \
            if (MODE == MODE_SEL) { if (kb_ + 63 > qlo_wave) mask_tile(p0, p1, qidx - kb_ - 4 * hi, 0x7fffffffu); } \
            else { if (kb_ + 63 > qlo_wave || kb_ + (int)W <= qlo_wave + 31) mask_tile(p0, p1, qidx - kb_ - 4 * hi, W); } \
            if (MODE == MODE_IMP) { \
                const float mnL = -m_reg * C2; \
                _Pragma("unroll") for (int r = 0; r < 16; ++r) { p0[r] = __builtin_amdgcn_exp2f(fmaf(p0[r], C2, mnL)) * rl; p1[r] = __builtin_amdgcn_exp2f(fmaf(p1[r], C2, mnL)) * rl; } \
                float G0[4], G1[4], PL0[4], PL1[4]; \
                _Pragma("unroll") for (int g4 = 0; g4 < 4; ++g4) { G0[g4] = (p0[4 * g4] + p0[4 * g4 + 1]) + (p0[4 * g4 + 2] + p0[4 * g4 + 3]); G1[g4] = (p1[4 * g4] + p1[4 * g4 + 1]) + (p1[4 * g4 + 2] + p1[4 * g4 + 3]); \
                    PL0[g4] = __shfl_xor(p0[4 * g4 + 3], 32); PL1[g4] = __shfl_xor(p1[4 * g4 + 3], 32); } \
                float* ip = (float*)(lds + L_IMP) + imp_row * 64 + (j - j_lo) * 16; \
                _Pragma("unroll") for (int g4 = 0; g4 < 4; ++g4) { \
                    const float prev0 = hi ? PL0[g4] : (g4 ? PL0[g4 - 1] : carry); \
                    const float prev1 = hi ? PL1[g4] : (g4 ? PL1[g4 - 1] : PL0[3]); \
                    ip[2 * g4 + hi] = G0[g4] + prev0; ip[8 + 2 * g4 + hi] = G1[g4] + prev1; } \
                carry = PL1[3]; \
            } else { \
                float mn, alpha; partialSM(p0, p1, m_reg, mn, alpha); \
                if (MODE != MODE_STATS) { if (__any(alpha < 1.f)) { if (hi == 0) wsf[r32] = alpha; asm volatile("s_waitcnt lgkmcnt(0)" ::: "memory"); \
                    _Pragma("unroll") for (int d_ = 0; d_ < 4; ++d_) _Pragma("unroll") for (int r = 0; r < 16; ++r) o[d_][r] *= wsf[crow(r, hi)]; } } \
                bf16x8 pa0, pa1, pa2, pa3; finishSM(p0, p1, alpha, l_reg, pa0, pa1, pa2, pa3); SBAR(); \
                if (MODE != MODE_STATS) pv_tile<KB>(o, vb0, vb2, pa0, pa1, pa2, pa3); \
            } \
        } \
        if (RING && issued_) asm volatile("s_waitcnt vmcnt(4)" ::: "memory"); else asm volatile("s_waitcnt vmcnt(0)" ::: "memory");     \
        __syncthreads(); \
        if (!more) break; \
        j = jn; }
    if constexpr (RING) { for (;;) { FA_STEP(0) FA_STEP(1) FA_STEP(2) } } else { for (;;) { FA_STEP(0) FA_STEP(1) } }
#undef FA_STEP
}
}
namespace fa {
constexpr unsigned W_INF = 1u << 20;
__device__ __forceinline__ int opq_s(int x) { asm volatile("" : "+s"(x)); return x; }
__device__ __forceinline__ int opq_v(int x) { asm volatile("" : "+v"(x)); return x; }
template <int EMODE>
__device__ __forceinline__ void branch_epilogue(const f32x16* o, float sc_row, float* wsf, float* scratch, bf16_t* outw  , int ldo, int r32, int hi, int tid) {
    if (hi == 0) wsf[r32] = sc_row;
    asm volatile("s_waitcnt lgkmcnt(0)" ::: "memory");
    float rs[16];
#pragma unroll
    for (int r = 0; r < 16; ++r) rs[r] = wsf[crow(r, hi)];
    const unsigned voff = (unsigned)tid * 16u;
#pragma unroll
    for (int rg = 0; rg < 4; ++rg) {
        f32x4 sv[4];
        if (EMODE == 1 || EMODE == 2) {
#pragma unroll
            for (int d0 = 0; d0 < 4; ++d0) sv[d0] = *(const f32x4*)((const char*)scratch + (rg * 4 + d0) * 8192 + voff);
        }
#pragma unroll
        for (int d0 = 0; d0 < 4; ++d0) {
            f32x4 v;
#pragma unroll
            for (int r4 = 0; r4 < 4; ++r4) v[r4] = o[d0][rg * 4 + r4] * rs[rg * 4 + r4];
            if (EMODE == 1 || EMODE == 2) v += sv[d0];
            if (EMODE == 0 || EMODE == 1) *(f32x4*)((char*)scratch + (rg * 4 + d0) * 8192 + voff) = v;
            else {
#pragma unroll
                for (int r4 = 0; r4 < 4; ++r4) { const float vn = __shfl_xor(v[r4], 1);
                    if ((r32 & 1) == 0) *(unsigned*)(outw + (size_t)crow(rg * 4 + r4, hi) * ldo + d0 * 32 + r32) = cvtpk(v[r4], vn); }
            }
        }
        asm volatile("" ::: "memory");
    }
    asm volatile("s_waitcnt lgkmcnt(0)" ::: "memory");
}

__device__ __forceinline__ void nsa_unit(char* lds, unsigned char* ws, int L, const int wid, const int probe = 0) {
    const int cur = 63 - (L & 63), bg = L >> 6, b = bg >> 1, g = bg & 1, t0 = cur * 64;
    const int tid = tid_of(wid), lane = tid & 63, r32 = lane & 31, hi = lane >> 5;
    const int r = wid >> 1, qh = (wid & 1) * 32, qi = qh + r32, t = t0 + qi;
    const unsigned char* pj = ws + WS_PROJ;
    bf16x8 qr[8];
#pragma unroll
    for (int d0 = 0; d0 < 8; ++d0) qr[d0] = *(const bf16x8*)((const bf16_t*)(pj + PJ_QN) + ((size_t)(b * 8 + g * 4 + r) * S_ + t) * 128 + d0 * 16 + hi * 8);
    float* wsf = (float*)(lds + L_WS) + wid * 64;
#define NSA_GATE(br) bf2f(((const bf16_t*)(ws + WS_PROJ + PJ_GL))[(size_t)(opq_s(b) * S_ + opq_v(t)) * 32 + g * 12 + r * 3 + (br)])
#define NSA_SCRATCH() ((float*)(ws + WS_SCR) + (size_t)opq_s((int)blockIdx.x) * (64 * 512))
#define NSA_OUTW() ((bf16_t*)(ws + (probe ? WS_MERGED : WS_ONSAB)) + (size_t)(opq_s(b) * S_ + t0 + qh) * 1024 + (g * 4 + r) * 128)
    f32x16 o[4]; float m_reg, l_reg;
#define FA_RESET() do { _Pragma("unroll") for (int d_ = 0; d_ < 4; ++d_) o[d_] = f32x16{}; m_reg = -1e30f; l_reg = 0.f; } while (0)
    {
        const bf16_t* kc = (const bf16_t*)(ws + WS_KCB) + (size_t)(b * 2 + g) * 256 * 128; const bf16_t* vc = (const bf16_t*)(ws + WS_VCB) + (size_t)(b * 2 + g) * 256 * 128;
        const KVSrc src{kc, vc, 128, 1, 0};
        const int qc = (t - 31) >> 4, qc_lo = (t0 + qh - 31) >> 4, ntc = (4 * cur + 3 + 63) >> 6;
        FA_RESET();
        run_branch<MODE_BAND>(lds, qr, src, 0, ntc, 0ull, qc, qc_lo, W_INF, 0ull, o, m_reg, l_reg, 0, wid);
        branch_prefetch<MODE_IMP>(lds, src, 0, ntc, 0ull, wid);
        { const float g0 = NSA_GATE(0); branch_epilogue<0>(o, l_reg > 0.f ? g0 / l_reg : 0.f, wsf, NSA_SCRATCH(), nullptr, 1024, r32, hi, tid); }
        run_branch<MODE_IMP, true>(lds, qr, src, 0, ntc, 0ull, qc, qc_lo, W_INF, 0ull, o, m_reg, l_reg, r * 64 + qi, wid);
    }
    const size_t hoff = (size_t)(b * 2 + g) * S_ * 128;
    const KVSrc wsrc{(const bf16_t*)(pj + PJ_KV + 4 * 16 * MiB) + hoff, (const bf16_t*)(pj + PJ_KV + 5 * 16 * MiB) + hoff, 128, 1, 0};
    const KVSrc ssrc{(const bf16_t*)(pj + PJ_KV + 2 * 16 * MiB) + hoff, (const bf16_t*)(pj + PJ_KV + 3 * 16 * MiB) + hoff, 128, 1, 0};
    const int wj_lo = cur >= 8 ? cur - 8 : 0;
    if (!(probe & 2)) branch_prefetch<MODE_BAND>(lds, wsrc, wj_lo, cur + 1, 0ull, wid);
    {
        const float* imp = (const float*)(lds + L_IMP); unsigned long long* selm = (unsigned long long*)(lds + L_SELM);
#pragma unroll 1
        for (int q8 = 0; q8 < 8; ++q8) {
            const int q = wid * 8 + q8, j = lane;
            float v = -1e30f;
            if (j <= cur) v = ((imp[(0 * 64 + q) * 64 + j] + imp[(1 * 64 + q) * 64 + j]) + imp[(2 * 64 + q) * 64 + j]) + imp[(3 * 64 + q) * 64 + j];
            if (j == 0 || j == cur || j == cur - 1) v = 1e9f;
            unsigned sb = __float_as_uint(v); sb = (sb & 0x80000000u) ? ~sb : (sb | 0x80000000u);
            const unsigned klo = (sb << 6) | (unsigned)(63 - j), khi = sb >> 26;
            const unsigned long long key = ((unsigned long long)khi << 32) | klo;
            int rank = 0;
#pragma unroll
            for (int i = 0; i < 64; ++i) {
                const unsigned long long ku = ((unsigned long long)(unsigned)__builtin_amdgcn_readlane((int)khi, i) << 32) | (unsigned)__builtin_amdgcn_readlane((int)klo, i);
                rank += (ku > key) ? 1 : 0; }
            const unsigned long long m = __ballot(rank < 16);
            if (lane == 0) selm[q] = m;
        }
        __syncthreads();
    }
    unsigned long long own, uni;
    {
        const unsigned long long* selm = (const unsigned long long*)(lds + L_SELM);
        own = selm[qi];
        unsigned long long x = selm[lane]; unsigned xl = (unsigned)x, xh = (unsigned)(x >> 32);
#pragma unroll
        for (int o_ = 1; o_ < 64; o_ <<= 1) { xl |= (unsigned)__shfl_xor((int)xl, o_); xh |= (unsigned)__shfl_xor((int)xh, o_); }
        uni = ((unsigned long long)(unsigned)__builtin_amdgcn_readfirstlane((int)xh) << 32) | (unsigned)__builtin_amdgcn_readfirstlane((int)xl);
    }
    if (!(probe & 2)) {
        FA_RESET();
        run_branch<MODE_BAND, true>(lds, qr, wsrc, wj_lo, cur + 1, 0ull, t, t0 + qh, 512u, 0ull, o, m_reg, l_reg, 0, wid);
        if (!(probe & 1)) branch_prefetch<MODE_SEL>(lds, ssrc, 0, cur + 1, uni, wid);
        { const float g2 = NSA_GATE(2); branch_epilogue<1>(o, g2 / l_reg, wsf, NSA_SCRATCH(), nullptr, 1024, r32, hi, tid); }
    }
    if (!(probe & 1)) {
        FA_RESET();
        if (probe & 2) branch_prefetch<MODE_SEL>(lds, ssrc, 0, cur + 1, uni, wid);
        run_branch<MODE_SEL, true>(lds, qr, ssrc, 0, cur + 1, uni, t, t0 + qh, 0u, own, o, m_reg, l_reg, 0, wid);
        { const float g1 = NSA_GATE(1); branch_epilogue<2>(o, g1 / l_reg, wsf, NSA_SCRATCH(), NSA_OUTW(), 1024, r32, hi, tid); }
    }
#undef FA_RESET
#undef NSA_GATE
#undef NSA_SCRATCH
#undef NSA_OUTW
}

__device__ __forceinline__ void dil_unit(char* lds, unsigned char* ws, int L, const int wid) {
    const int cfg = L >> 9, rem = L & 511, bh = rem >> 4, pt = rem & 15, b = bh >> 2, h = bh & 3;
    const int dl = cfg * 2, d = 1 << dl, ntile = 16 >> dl;
    const int u = pt / ntile, p0 = (pt % ntile) * 256;
    const int tid = tid_of(wid), lane = tid & 63, r32 = lane & 31, hi = lane >> 5;
    const int p = p0 + wid * 32 + r32, tok = b * S_ + p * d + u;
    const unsigned char* pj = ws + WS_PROJ;
    const size_t hrow0 = (size_t)(b * 4 + h) * S_;
    const int ls = S_ >> dl;
    bf16x8 qr[8];
#pragma unroll
    for (int d0 = 0; d0 < 8; ++d0) qr[d0] = *(const bf16x8*)((const bf16_t*)(pj + PJ_DIL + (size_t)(cfg * 3 + 0) * 32 * MiB) + (hrow0 + (size_t)u * ls + p) * 128 + d0 * 16 + hi * 8);
    const KVSrc src{(const bf16_t*)(pj + PJ_DIL + (size_t)(cfg * 3 + 1) * 32 * MiB) + (hrow0 + (size_t)u * ls) * 128, (const bf16_t*)(pj + PJ_DIL + (size_t)(cfg * 3 + 2) * 32 * MiB) + (hrow0 + (size_t)u * ls) * 128, 128, 1, 0};
    f32x16 o[4];
#pragma unroll
    for (int d_ = 0; d_ < 4; ++d_) o[d_] = f32x16{};
    float m_reg = -1e30f, l_reg = 0.f;
    run_branch<MODE_BAND>(lds, qr, src, p0 >= 128 ? (p0 - 128) >> 6 : 0, (p0 >> 6) + 4, 0ull, p, p0 + wid * 32, 129u, 0ull, o, m_reg, l_reg, 0, wid);
    float* wsf = (float*)(lds + L_WS) + wid * 64;
    bf16_t* outw = (bf16_t*)(ws + WS_ODP) + (size_t)cfg * T_ * 512 + (size_t)(b * S_ + (p0 + wid * 32) * d + u) * 512 + h * 128;
    branch_epilogue<3>(o, 1.f / l_reg, wsf, nullptr, outw, 512 * d, r32, hi, tid);
    if (hi == 0) ((float*)(ws + WS_LSE))[(size_t)cfg * T_ * 4 + (size_t)tok * 4 + h] = m_reg * SCALE + logf(l_reg);
}

__device__ __forceinline__ void dil_combine(unsigned char* ws, int gt, int NGT) {
    const bf16_t* od = (const bf16_t*)(ws + WS_ODP); const float* lse = (const float*)(ws + WS_LSE); bf16_t* o = (bf16_t*)(ws + WS_ODILB);
    for (size_t i = (size_t)gt; i < (size_t)T_ * 64; i += NGT) {
        const size_t tok = i >> 6; const int c8 = (int)(i & 63) * 8, h = c8 >> 7;
        const float l0 = lse[tok * 4 + h], l1 = lse[(size_t)T_ * 4 + tok * 4 + h], l2 = lse[(size_t)2 * T_ * 4 + tok * 4 + h];
        const float m = fmaxf(l0, fmaxf(l1, l2)); float e0 = expf(l0 - m), e1 = expf(l1 - m), e2 = expf(l2 - m); const float inv = 1.f / (e0 + e1 + e2); e0 *= inv; e1 *= inv; e2 *= inv;
        const u32x4 a0 = *(const u32x4*)(od + tok * 512 + c8), a1 = *(const u32x4*)(od + (size_t)T_ * 512 + tok * 512 + c8), a2 = *(const u32x4*)(od + (size_t)2 * T_ * 512 + tok * 512 + c8);
        u32x4 w;
#pragma unroll
        for (int k = 0; k < 4; ++k) {
            const float lo = e0 * __uint_as_float(a0[k] << 16) + e1 * __uint_as_float(a1[k] << 16) + e2 * __uint_as_float(a2[k] << 16);
            const float hi_ = e0 * __uint_as_float(a0[k] & 0xffff0000u) + e1 * __uint_as_float(a1[k] & 0xffff0000u) + e2 * __uint_as_float(a2[k] & 0xffff0000u);
            w[k] = cvtpk(lo, hi_);
        }
        *(u32x4*)(o + tok * 512 + c8) = w;
    }
}

constexpr int CP_LD = 144;
constexpr int CP_A = 0, CP_B = 2 * 32 * CP_LD, CP_HID = CP_B + 2 * 256 * CP_LD, CP_HLD = 528;
static_assert(CP_HID + 32 * CP_HLD <= LDSCTL_OFF, "compress LDS map");
__device__ __forceinline__ void compress_unit(char* lds, unsigned char* ws, int unit, const int wid) {
    const int which = unit >> 7, R0 = (unit & 127) * 32;
    const int tid = tid_of(wid), lane = tid & 63, n32 = lane & 31, hi = lane >> 5;
    const bf16_t* w1t = (const bf16_t*)(ws + WS_CW1) + (size_t)which * 256 * 4096;
    const bf16_t* w2t = (const bf16_t*)(ws + WS_CW2) + (size_t)which * 128 * 256;
    const float* posb = (const float*)(ws + WS_POSB) + which * 16 * 256;
    const int ar = (tid >> 3) & 31, ap = tid & 7;
    const int Rr = R0 + ar, bgc = Rr >> 8, c = (Rr & 255) < 254 ? (Rr & 255) : 254, bb = bgc >> 1, gg = bgc & 1;
    const bf16_t* asrc = (const bf16_t*)(ws + WS_PROJ + PJ_KV + (size_t)(which ? 1 : 0) * 16 * MiB) + ((size_t)(bb * 2 + gg) * S_ + 16 * c) * 128 + ap * 8;
    bf16x8 sa0, sa1, sa2, sa3, sb0[4], sb1[4], sb2[4], sb3[4];
#define CP_LOAD(S, kt) do { if (tid < 256) sa##S = *(const bf16x8*)(asrc + (size_t)((kt) >> 1) * 128 + ((kt) & 1) * 64); \
        _Pragma("unroll") for (int i = 0; i < 4; ++i) { const int idx = tid + 512 * i; sb##S[i] = *(const bf16x8*)(w1t + (size_t)(idx >> 3) * 4096 + (kt) * 64 + (idx & 7) * 8); } } while (0)
#define CP_WRITE(S, bf) do { if (tid < 256) *(bf16x8*)(lds + CP_A + (bf) * 32 * CP_LD + ar * CP_LD + ap * 16) = sa##S; \
        _Pragma("unroll") for (int i = 0; i < 4; ++i) { const int idx = tid + 512 * i; *(bf16x8*)(lds + CP_B + (bf) * 256 * CP_LD + (idx >> 3) * CP_LD + (idx & 7) * 16) = sb##S[i]; } } while (0)
#define CP_STEP(k, LS, WS) do { const int k_ = (k); \
        if (k_ + 3 < 64) CP_LOAD(LS, k_ + 3); \
        { const char* ab = lds + CP_A + (k_ & 1) * 32 * CP_LD + n32 * CP_LD + hi * 16; \
          const char* bbp = lds + CP_B + (k_ & 1) * 256 * CP_LD + (wid * 32 + n32) * CP_LD + hi * 16; \
          _Pragma("unroll") for (int ks = 0; ks < 4; ++ks) { const bf16x8 af = *(const bf16x8*)(ab + ks * 32), bfv = *(const bf16x8*)(bbp + ks * 32); acc = __builtin_amdgcn_mfma_f32_32x32x16_bf16(af, bfv, acc, 0, 0, 0); } } \
        if (k_ + 1 < 64) { if (k_ + 3 < 64) asm volatile("s_waitcnt vmcnt(8)" ::: "memory"); else if (k_ + 2 < 64) asm volatile("s_waitcnt vmcnt(4)" ::: "memory"); else asm volatile("s_waitcnt vmcnt(0)" ::: "memory"); \
            CP_WRITE(WS, (k_ + 1) & 1); } \
        __syncthreads(); } while (0)
    f32x16 acc = f32x16{};
    CP_LOAD(0, 0); CP_LOAD(1, 1); CP_LOAD(2, 2);
    asm volatile("s_waitcnt vmcnt(8)" ::: "memory"); CP_WRITE(0, 0); __syncthreads();
#pragma unroll 1
    for (int kt = 0; kt < 64; kt += 4) {
        CP_STEP(kt, 3, 1); CP_STEP(kt + 1, 0, 2); CP_STEP(kt + 2, 1, 3); CP_STEP(kt + 3, 2, 0);
    }
#undef CP_LOAD
#undef CP_WRITE
#undef CP_STEP
    { float pb = 0.f;
#pragma unroll
      for (int c = 0; c < 16; ++c) pb += posb[c * 256 + wid * 32 + n32];
#pragma unroll
      for (int r = 0; r < 16; ++r) { const float hv = gelu_tanh(acc[r] + pb); const unsigned pk = cvtpk(hv, 0.f); *(bf16_t*)(lds + CP_HID + crow(r, hi) * CP_HLD + (wid * 32 + n32) * 2) = (bf16_t)pk; } }
    __syncthreads();
    if (wid < 4) {
        f32x16 a2 = f32x16{};
#pragma unroll
        for (int ks = 0; ks < 16; ++ks) {
            const bf16x8 af = *(const bf16x8*)(lds + CP_HID + n32 * CP_HLD + ks * 32 + hi * 16);
            const bf16x8 bfv = *(const bf16x8*)(w2t + (size_t)(wid * 32 + n32) * 256 + ks * 16 + hi * 8);
            a2 = __builtin_amdgcn_mfma_f32_32x32x16_bf16(af, bfv, a2, 0, 0, 0);
        }
        bf16_t* outp = (bf16_t*)(ws + (which ? WS_VCB : WS_KCB));
#pragma unroll
        for (int r = 0; r < 16; ++r) { const float v = a2[r], vn = __shfl_xor(v, 1);
            if ((n32 & 1) == 0) *(unsigned*)(outp + (size_t)(R0 + crow(r, hi)) * 128 + wid * 32 + n32) = cvtpk(v, vn); }
    }
    __syncthreads();
}
}
#ifndef F8_FUDGE
#define F8_FUDGE 1.f
#endif
#ifndef PROBE_NSA_FLAGS
#define PROBE_NSA_FLAGS 0
#endif
#ifndef PROBE_ATT_PART
#define PROBE_ATT_PART 0
#endif
#ifndef PROBE_DUP
#define PROBE_DUP (-1)
#endif
#define REPS(ph) for (int rep_ = 0; rep_ < ((PROBE_DUP) == (ph) ? 2 : 1); ++rep_)
enum { PH_PROLOGUE = 0, PH_INPROJ, PH_COMPRESS, PH_ATTN, PH_BRA, PH_BRB, PH_WOUT, PH_LN1, PH_SCATTER, PH_UP, PH_DOWN, PH_FINAL, PH_COUNT };
__global__ void __launch_bounds__(NWAVES * 64, 2) mk_fwd(Args args) {
    extern __shared__ __attribute__((aligned(16))) unsigned char lds_raw[];
    Frame F;
    F.lds = (LAS unsigned char*)lds_raw;
    F.MISC = (volatile LAS unsigned*)(F.lds + MISC_OFF);
    F.tid = threadIdx.x; F.lane = F.tid & 63; F.wave = __builtin_amdgcn_readfirstlane(F.tid >> 6);
    F.G = gridDim.x; { const int bx = blockIdx.x; F.vcu = (F.G % 8 == 0) ? (bx % 8) * (F.G / 8) + bx / 8 : bx; }
    unsigned char* ws = args.ws;
    F.ctl = (unsigned*)(ws + WS_CTL);
    for (int u = F.tid; u < (LDS_BYTES - LDSCTL_OFF) / 4; u += NWAVES * 64) ((LAS unsigned*)(F.lds + LDSCTL_OFF))[u] = 0u;
    __syncthreads();
    XcdBarrier bar = xcd_barrier_post(F.ctl + CW_BAR + args.li * XCD_BAR_WORDS, F.MISC + 8);
    const int lo = args.ph_lo, hi = args.ph_hi;
#define IN(k) (lo <= (k) && (k) < hi)
#define REFRAME() do { const int t_ = tid_of(F.wave); F.tid = t_; F.lane = t_ & 63; } while (0)
#define BOTH(k) (IN(k) && IN((k) + 1))
    if (IN(PH_PROLOGUE)) { REFRAME(); REPS(PH_PROLOGUE) p0_prologue(F, args); if (BOTH(PH_PROLOGUE)) xcd_barrier(bar, tid_of(F.wave) == 0); }
    if (IN(PH_INPROJ)) {
        pg8::Gemm g{(const bf16_t*)(ws + WS_XB), (const bf16_t*)(ws + WS_WIN), DM, nullptr};
        pg8::StaticOrder S; S.init(T_ / 256, 44, F.G, (int)blockIdx.x);
        pg8::EpiInProj E{ws + WS_PROJ, (const float*)(ws + WS_BINP), (const float*)(ws + WS_ROPE), (const float*)(ws + WS_ROPE) + 4096 * 64};
        REPS(PH_INPROJ) pg8::gemm_phase<pg8::EpiInProj, pg8::StaticOrder, false>(F.lds + RING_OFF, g, S, E, F.wave);
#ifdef PROBE_NULL_INPROJ
        { pg8::EpiNull EN; pg8::gemm_phase<pg8::EpiNull, pg8::StaticOrder, false>(F.lds + RING_OFF, g, S, EN, F.wave); }
#endif
        if (BOTH(PH_INPROJ)) xcd_barrier(bar, tid_of(F.wave) == 0);
    }
    if (IN(PH_COMPRESS)) { REFRAME();
        REPS(PH_COMPRESS) for (int u = (int)blockIdx.x; u < 256; u += F.G) fa::compress_unit((char*)lds_raw, ws, u, F.wave);
        if (BOTH(PH_COMPRESS)) xcd_barrier(bar, tid_of(F.wave) == 0);
    }
    if (IN(PH_ATTN)) { REFRAME();
        volatile LAS int* qslot = (volatile LAS int*)(F.lds + fa::L_MISC);
        LAS float* tscr = (LAS float*)(F.lds + F.wave * SCR_WAVE_BYTES);
#define MOE_W_POP() ({ if (F.tid == 0) qslot[1] = (int)atomicAdd(F.ctl + CW_QUEUE + 256 + rep_ * 16, (unsigned)MOE_W_BATCH); __syncthreads(); const int i0_ = __builtin_amdgcn_readfirstlane(qslot[1]); __syncthreads(); \
            moe_w_batch(args, i0_, (i0_ + MOE_W_BATCH < MOE_W_ITEMS ? i0_ + MOE_W_BATCH : MOE_W_ITEMS), tscr, F.wave, F.lane); __syncthreads(); i0_ < MOE_W_ITEMS; })
        REPS(PH_ATTN) {
        bool more_w = true;
        if ((((int)blockIdx.x >> 3) & 3) == 0) {
#pragma unroll 1
            while (more_w) more_w = MOE_W_POP();
        }
#pragma unroll 1
        for (;;) {
            if (F.tid == 0) qslot[0] = (int)atomicAdd(F.ctl + CW_QUEUE + rep_ * 128, 1u);
            __syncthreads();
            const int L = __builtin_amdgcn_readfirstlane(qslot[0]);
            __syncthreads();
            if (L >= 1024) break;
            if (rep_ == 1 && (PROBE_ATT_PART == 2 || PROBE_ATT_PART == 3)) continue;
            fa::nsa_unit((char*)lds_raw, ws, L, F.wave, rep_ == 1 ? PROBE_NSA_FLAGS : 0);
        }
        int ndil = 0;
#pragma unroll 1
        for (;;) {
            if (F.tid == 0) qslot[0] = (int)atomicAdd(F.ctl + CW_QUEUE + 64 + rep_ * 128, 1u);
            __syncthreads();
            const int L = __builtin_amdgcn_readfirstlane(qslot[0]);
            __syncthreads();
            if (L >= 1536) break;
            if (rep_ == 1 && (PROBE_ATT_PART == 1 || PROBE_ATT_PART == 3)) continue;
            fa::dil_unit((char*)lds_raw, ws, L, F.wave);
        }
#pragma unroll 1
        while (more_w) more_w = MOE_W_POP();
        }
#undef MOE_W_POP
        if (BOTH(PH_ATTN)) xcd_barrier(bar, tid_of(F.wave) == 0);
    }
    if (IN(PH_BRA)) { REFRAME();
        fa::dil_combine(ws, (F.vcu * NWAVES + F.wave) * 64 + F.lane, F.G * NWAVES * 64);
        xcd_barrier(bar, tid_of(F.wave) == 0);
        pg8::Gemm g{(const bf16_t*)(ws + WS_ONSAB), (const bf16_t*)(ws + WS_WBA), 1024, nullptr, (const bf16_t*)(ws + WS_ODILB), (const bf16_t*)(ws + WS_WBD), 512};
        pg8::StaticOrder S; S.init(T_ / 256, DM / 256, F.G, (int)blockIdx.x);
        pg8::EpiBr2 E{(bf16_t*)(ws + WS_MERGED), (const bf16_t*)(ws + WS_PROJ + PJ_GA), (const bf16_t*)(ws + WS_PROJ + PJ_GB)};
        REPS(PH_BRA) pg8::gemm_phase<pg8::EpiBr2, pg8::StaticOrder, false, false, true>(F.lds + RING_OFF, g, S, E, F.wave);
        if (BOTH(PH_BRA)) xcd_barrier(bar, tid_of(F.wave) == 0);
    }
    if (IN(PH_BRB)) { }
    if (IN(PH_WOUT)) {
        pg8::Gemm g{(const bf16_t*)(ws + WS_MERGED), (const bf16_t*)(ws + WS_WOUT), DM, nullptr};
        pg8::StaticOrder S; S.init(T_ / 256, DM / 256, F.G, (int)blockIdx.x);
        pg8::EpiWout E{(bf16_t*)(ws + WS_Z)};
        REPS(PH_WOUT) pg8::gemm_phase<pg8::EpiWout, pg8::StaticOrder, false>(F.lds + RING_OFF, g, S, E, F.wave);
        if (BOTH(PH_WOUT)) xcd_barrier(bar, tid_of(F.wave) == 0);
    }
    if (IN(PH_LN1)) { REFRAME(); p_ln1_router(F, args); if (BOTH(PH_LN1)) xcd_barrier(bar, tid_of(F.wave) == 0); }
    if (IN(PH_SCATTER)) { REFRAME(); p_scatter(F, args); if (BOTH(PH_SCATTER)) xcd_barrier(bar, tid_of(F.wave) == 0); }
    if (IN(PH_UP)) {
        const int ntiles = (int)__hip_atomic_load(F.ctl + CW_NTILES, __ATOMIC_RELAXED, __HIP_MEMORY_SCOPE_AGENT);
        pg8::Gemm g{(const bf16_t*)(ws + WS_HB), (const bf16_t*)(ws + WS_WUP), DM, (const int*)(ws + WS_ROUTE + 4 * 512 * 1024)};
        { LAS unsigned* tel = (LAS unsigned*)(F.lds + RING_BYTES); for (int i = F.tid; i < MOE_TILES; i += NWAVES * 64) tel[i] = F.ctl[CW_TILEEXP + i]; __syncthreads(); }
        pg8::ExpertOrder S; S.so.init(ntiles, 16, F.G, (int)blockIdx.x); S.tile_exp = (const LAS unsigned*)(F.lds + RING_BYTES);
        pg8::EpiSwigluT<true> E{(unsigned char*)(ws + WS_ACT), (const float*)(ws + WS_BUPP), 1.f / (W8_SCALE * F8_FUDGE)};
        REPS(PH_UP) pg8::gemm_phase<pg8::EpiSwigluT<true>, pg8::ExpertOrder, true, true>(F.lds + RING_OFF, g, S, E, F.wave);
#ifdef PROBE_NULL_UP
        { pg8::EpiNull EN; pg8::gemm_phase<pg8::EpiNull, pg8::ExpertOrder, true, true>(F.lds + RING_OFF, g, S, EN, F.wave); }
#endif
        if (BOTH(PH_UP)) xcd_barrier(bar, tid_of(F.wave) == 0);
    }
    if (IN(PH_DOWN)) {
        const int ntiles = (int)__hip_atomic_load(F.ctl + CW_NTILES, __ATOMIC_RELAXED, __HIP_MEMORY_SCOPE_AGENT);
        pg8::Gemm g{(const bf16_t*)(ws + WS_ACT), (const bf16_t*)(ws + WS_WDN), DM, nullptr};
        { LAS unsigned* tel = (LAS unsigned*)(F.lds + RING_BYTES); for (int i = F.tid; i < MOE_TILES; i += NWAVES * 64) tel[i] = F.ctl[CW_TILEEXP + i]; __syncthreads(); }
        pg8::ExpertOrder S; S.so.init(ntiles, 8, F.G, (int)blockIdx.x); S.tile_exp = (const LAS unsigned*)(F.lds + RING_BYTES);
        pg8::EpiDown E{(unsigned char*)(ws + WS_Y), args.in[19], (const float*)(ws + WS_ROUTE + 4 * 512 * 1024 + 544 * 1024), 1.f / (W8_SCALE * F8_FUDGE)};
        REPS(PH_DOWN) pg8::gemm_phase<pg8::EpiDown, pg8::ExpertOrder, false, true>(F.lds + RING_OFF, g, S, E, F.wave);
        if (BOTH(PH_DOWN)) xcd_barrier(bar, tid_of(F.wave) == 0);
    }
    if (IN(PH_FINAL)) { REFRAME(); REPS(PH_FINAL) p_final(F, args); }
#undef IN
#undef BOTH
}
static int g_grid = 0;
static void mk_launch(const Args& base, int lo, int hi, int li, hipStream_t stream) {
    Args a = base; a.ph_lo = lo; a.ph_hi = hi; a.li = li; a.pad = 0;
    hipLaunchKernelGGL(mk_fwd, dim3(g_grid), dim3(NWAVES * 64), LDS_BYTES, stream, a);
}
extern "C" void kernel_launch(void* const* d_in, const int* in_sizes, int n_in, void* d_out, int out_size, void* d_ws, size_t ws_size, hipStream_t stream) {
    if (g_grid == 0) {
        if (n_in != 22 || ws_size < WS_END) { fprintf(stderr, "kernel_launch: bad args n_in=%d ws=%zu need %zu\n", n_in, ws_size, (size_t)WS_END); g_grid = -1; return; }
        int dev = 0, cus = 0, per_cu = 0;
        if (hipGetDevice(&dev) != hipSuccess || hipDeviceGetAttribute(&cus, hipDeviceAttributeMultiprocessorCount, dev) != hipSuccess) { g_grid = -1; return; }
        if (hipFuncSetAttribute((const void*)mk_fwd, hipFuncAttributeMaxDynamicSharedMemorySize, LDS_BYTES) != hipSuccess) { fprintf(stderr, "hipFuncSetAttribute failed\n"); g_grid = -1; return; }
        if (hipOccupancyMaxActiveBlocksPerMultiprocessor(&per_cu, (const void*)mk_fwd, NWAVES * 64, LDS_BYTES) != hipSuccess || per_cu < 1) fprintf(stderr, "occupancy query: %d\n", per_cu);
        (void)hipGetLastError();
        g_grid = cus;
    }
    if (g_grid < 0) return;
    Args p{}; for (int i = 0; i < 22; ++i) p.in[i] = (const float*)d_in[i]; p.out = (float*)d_out; p.ws = (unsigned char*)d_ws;
    unsigned char* ws = p.ws;
    (void)hipMemsetAsync(ws + WS_CTL, 0, 1 * MiB, stream);
#ifndef MK_N_LAUNCHES
#define MK_N_LAUNCHES 1
#endif
    if (MK_N_LAUNCHES == 1) mk_launch(p, 0, PH_COUNT, 0, stream);
    else { mk_launch(p, PH_PROLOGUE, PH_INPROJ + 1, 0, stream); for (int ph = PH_COMPRESS; ph <= PH_FINAL; ++ph) mk_launch(p, ph, ph + 1, 1, stream); }
}
```

```cpp
#include <hip/hip_runtime.h>
#include <cstdio>
#include <cstdint>
#include <cmath>

constexpr int NB = 8, S_ = 4096, DM = 2048, T_ = NB * S_, HD = 128;
constexpr int IN_W = 11288, LDP = 11520;
constexpr int C_QN = 0, C_KC = 1024, C_VC = 1280, C_KS = 1536, C_VS = 1792, C_KW = 2048, C_VW = 2304;
constexpr int C_DIL = 2560;
constexpr int C_GA = 7168, C_GB = 9216, C_GL = 11264;
constexpr int NEXP = 32, TOPK = 4, MOE_ROWS = T_ * TOPK + NEXP * 256, MOE_TILES = MOE_ROWS / 256;
constexpr float DN_ALPHA = 1.189207115002721f;
constexpr float LN_EPS = 1e-5f;
constexpr float ATT_SCALE = 0.08838834764831845f;

__host__ __device__ __forceinline__ int wcol_of(int c) {
    if (c < 2560) return c;
    if (c < 11264) return c + 24;
    if (c < 11288) return c - 11264 + 2560;
    return -1;
}
__host__ __device__ __forceinline__ bool is_rope_tile(int pn) { return pn < 5 || pn == 6 || pn == 8 || (pn >= 10 && pn < 28 && ((pn - 10) % 6) < 4); }
__host__ __device__ __forceinline__ int inproj_phys2log(int pn, int p) { if (!is_rope_tile(pn)) return p; const int bj = p >> 7, hl = (p >> 6) & 1, d = p & 63; return hl * 128 + bj * 64 + d; }

typedef unsigned short bf16_t;
typedef short bf16x8 __attribute__((ext_vector_type(8)));
typedef float f32x4 __attribute__((ext_vector_type(4)));
typedef float f32x16 __attribute__((ext_vector_type(16)));
typedef unsigned u32x4 __attribute__((ext_vector_type(4)));
typedef unsigned u32x2 __attribute__((ext_vector_type(2)));
#define LAS __attribute__((address_space(3)))
#define GAS __attribute__((address_space(1)))

__device__ __forceinline__ float bf2f(bf16_t v) { return __uint_as_float((unsigned)v << 16); }
__device__ __forceinline__ unsigned cvt_pk_bf16(float lo, float hi) { unsigned r; asm volatile("v_cvt_pk_bf16_f32 %0, %1, %2" : "=v"(r) : "v"(lo), "v"(hi)); return r; }
__device__ __forceinline__ float sigm(float x) { return 1.f / (1.f + expf(-x)); }
__device__ __forceinline__ float sigm_fast(float x) { return __builtin_amdgcn_rcpf(1.f + __builtin_amdgcn_exp2f(-1.4426950408889634f * x)); }
__device__ __forceinline__ float gelu_tanh(float x) { return 0.5f * x * (1.f + tanhf(0.7978845608028654f * (x + 0.044715f * x * x * x))); }
__device__ __forceinline__ int tid_of(int wave) { int l; asm volatile("v_mbcnt_lo_u32_b32 %0, -1, 0\n\tv_mbcnt_hi_u32_b32 %0, -1, %0" : "=v"(l)); return (wave << 6) | l; }
__device__ __forceinline__ float wave_sum(float v) { for (int o = 1; o < 64; o <<= 1) v += __shfl_xor(v, o); return v; }

constexpr size_t MiB = 1ull << 20;
constexpr size_t WS_CTL = 0;
constexpr size_t WS_ROPE = 1 * MiB;
constexpr size_t WS_KC = 3 * MiB;
constexpr size_t WS_VC = 5 * MiB;
constexpr size_t WS_SELM = 7 * MiB;
constexpr size_t WS_ROUTE = 8 * MiB;
constexpr size_t WS_LSE = 12 * MiB;
constexpr size_t WS_BINP = 14 * MiB;
constexpr size_t WS_BUPP = WS_BINP + 64 * 1024;
constexpr size_t WS_KCB = 15 * MiB;
constexpr size_t WS_VCB = 16 * MiB;
constexpr size_t WS_W = 20 * MiB;
constexpr size_t WS_WIN = WS_W;
constexpr size_t WS_WBA = WS_WIN + 45 * MiB;
constexpr size_t WS_WBD = WS_WBA + 4 * MiB;
constexpr size_t WS_WOUT = WS_WBD + 2 * MiB;
constexpr size_t WS_CW1 = WS_WOUT + 8 * MiB;
constexpr size_t WS_CW2 = WS_CW1 + 4 * MiB;
constexpr size_t WS_WUP = WS_CW2 + 1 * MiB;
constexpr size_t WS_WDN = WS_WUP + 512 * MiB;
constexpr size_t WS_XB = WS_WDN + 256 * MiB;
constexpr size_t WS_PROJ = WS_XB + 128 * MiB;
constexpr size_t WS_ONSA = WS_PROJ + 720 * MiB;
constexpr size_t WS_ODP = WS_ONSA + 128 * MiB;
constexpr size_t WS_ODIL = WS_ODP + 192 * MiB;
constexpr size_t WS_MERGED = WS_ODIL + 64 * MiB;
constexpr size_t WS_Z = WS_MERGED + 256 * MiB;
constexpr size_t WS_HB = WS_Z + 256 * MiB;
constexpr size_t PJ_QN = 0;
constexpr size_t PJ_KV = 64 * MiB;
constexpr size_t PJ_DIL = 160 * MiB;
constexpr size_t PJ_GA = 448 * MiB;
constexpr size_t PJ_GB = 576 * MiB;
constexpr size_t PJ_GL = 704 * MiB;
__host__ __device__ __forceinline__ int dil_row(int cfg, int t) { const int dl = 2 * cfg; return ((t & ((1 << dl) - 1)) << (12 - dl)) + (t >> dl); }
constexpr size_t WS_ONSAB = WS_ONSA;
constexpr size_t WS_ODILB = WS_ODIL;
constexpr size_t WS_SCR = WS_MERGED + 128 * MiB;
constexpr size_t WS_POSB = WS_BUPP + 512 * 1024;
constexpr size_t WS_ACT = WS_PROJ;
constexpr size_t WS_Y = WS_HB + 128 * MiB;
constexpr size_t WS_WRT = WS_POSB + 64 * 1024;
constexpr size_t WS_H = WS_Y + 600 * MiB;
constexpr size_t WS_END = WS_Y + 1088 * MiB;
static_assert(WS_END <= 4096 * MiB, "ws map");
constexpr int CW_CNT = 64;
constexpr int CW_NTILES = 128;
constexpr int CW_PADSTART = 192;
constexpr int CW_TILEEXP = 256;
constexpr int CW_TEST = 960;
constexpr int CW_QUEUE = 1024;
constexpr int CW_BAR = 4096;

struct Args { const float* in[22]; float* out; unsigned char* ws; int ph_lo, ph_hi, li, pad; };
typedef Args P;
#ifndef F8_EXPERIMENT
#define F8_EXPERIMENT 0
#endif
namespace pg8 {
typedef int v4i_t __attribute__((ext_vector_type(4)));
typedef int v8i_t __attribute__((ext_vector_type(8)));
#define PG8_LAS __attribute__((address_space(3)))
constexpr int BM = 256, BK = 64, HALF = 128, HTB = HALF * BK * 2, STAGE_BYTES = 8 * HTB, NXCD = 8, WGM = 8;
__host__ __device__ __forceinline__ int lds_byte(int r, int c) { const int st = (r >> 4) * 2 + (c >> 5), rr = r & 15, cc = c & 31, ob = rr * 64 + cc * 2; return st * 1024 + (ob ^ (((ob >> 9) & 1) << 5)); }
__host__ __device__ __forceinline__ void stage_rc(int b, int& R, int& C) { const int st = b / 1024, sb = b % 1024, swz = sb ^ (((sb >> 9) & 1) << 5); R = (st >> 1) * 16 + swz / 64; C = (st & 1) * 32 + (swz % 64) / 2; }
__host__ __device__ __forceinline__ int perm32(int rho) { const int n = rho >> 4, i = rho & 15; return 8 * (i >> 2) + 4 * n + (i & 3); }

struct Unit { int pm, pn, pb; };
struct Gemm { const bf16_t* A; const bf16_t* Bt; int K; const int* arows; const bf16_t* A2 = nullptr; const bf16_t* Bt2 = nullptr; int K2 = 0; };

struct StaticOrder {
    int nM, nN, nwg, G, c;
    __device__ void init(int nM_, int nN_, int G_, int c_) { nM = nM_; nN = nN_; nwg = nM * nN; G = G_; c = c_; }
    __device__ bool next(int i, Unit& u) const {
        const long L = (long)i * G + c; if (L >= nwg) return false;
        int wgid = (int)L; { const int q = nwg / NXCD, r = nwg % NXCD, xcd = wgid % NXCD, off = wgid / NXCD; wgid = (xcd < r ? xcd * (q + 1) : r * (q + 1) + (xcd - r) * q) + off; }
        const int nig = WGM * nN, gid = wgid / nig, fm = gid * WGM, gsz = (nM - fm) < WGM ? (nM - fm) : WGM;
        u.pm = fm + ((wgid % nig) % gsz); u.pn = (wgid % nig) / gsz; u.pb = u.pn; return true;
    }
};
struct ExpertOrder {
    StaticOrder so; const PG8_LAS unsigned* tile_exp;
    __device__ bool next(int i, Unit& u) const { if (!so.next(i, u)) return false; u.pb = (int)tile_exp[u.pm] * so.nN + u.pn; return true; }
};

template <class Epi, class Sched, bool GATHER, bool F8 = false, bool SEG2 = false>
__device__ __forceinline__ void gemm_phase(PG8_LAS unsigned char* lds, const Gemm g, const Sched& S, const Epi& E, const int wid) {
    const int tid = tid_of(wid), lane = tid & 63, wr = wid >> 2, wc = wid & 3, fr = lane & 15, fq = lane >> 4;
    const int K = g.K, RB = F8 ? K : K * 2, nt1 = F8 ? K / 128 : K / BK, RB2 = SEG2 ? g.K2 * 2 : RB, nt = SEG2 ? nt1 + g.K2 / BK : nt1;
    unsigned voffA[2], voffB[2], voffA2[2], voffB2[2]; int rA[2], cA2[2];
#pragma unroll
    for (int i = 0; i < 2; ++i) { int R, CB;
        { int C; stage_rc(tid * 16 + i * 8192, R, C); CB = C * 2; }
        const int Rb = (R & ~31) + perm32(R & 31);
        voffA[i] = (unsigned)(R * RB + CB); voffB[i] = (unsigned)(Rb * RB + CB); voffA2[i] = (unsigned)(R * RB2 + CB); voffB2[i] = (unsigned)(Rb * RB2 + CB); rA[i] = R; cA2[i] = CB; }
    const size_t kstep = 128;
    const size_t hstep = (size_t)HALF * RB;
    const size_t tstep = 2 * hstep;
    const size_t hstep2 = (size_t)HALF * RB2, tstep2 = 2 * hstep2;
    const unsigned ldsw = (unsigned)wid * 1024u;
    const int aoff = lds_byte(wr * 64 + fr, fq * 8), boff = lds_byte(wc * 32 + fr, fq * 8);
#define PG8_SA(b, h) (((b) * 2 + (h)) * HTB)
#define PG8_SB(b, h) ((4 + (b) * 2 + (h)) * HTB)
#define PG8_STAGE(bufoff, gbase, voff) do { _Pragma("unroll") for (int _i = 0; _i < 2; ++_i) \
        __builtin_amdgcn_global_load_lds((const unsigned*)((const char*)(gbase) + (voff)[_i]), (PG8_LAS unsigned*)(lds + (bufoff) + ldsw + _i * 8192), 16, 0, 0); } while (0)
#define PG8_STAGE_A(bufoff, gbase, h, par) do { if constexpr (GATHER) { unsigned vg_[2]; _Pragma("unroll") for (int _i = 0; _i < 2; ++_i) vg_[_i] = rowtab[(par) * 256 + (h) * HALF + rA[_i]] * (unsigned)RB + (unsigned)cA2[_i]; PG8_STAGE(bufoff, gbase, vg_); } \
        else { PG8_STAGE(bufoff, (gbase) + (h) * hstep, voffA); } } while (0)
#define PG8_STAGE_AX(bufoff, gbase, h, par, HS, VO) do { if constexpr (GATHER) { PG8_STAGE_A(bufoff, gbase, h, par); } else { PG8_STAGE(bufoff, (gbase) + (h) * (HS), VO); } } while (0)
#define PG8_LDA(dst, b, h) do { _Pragma("unroll") for (int m = 0; m < 4; ++m) { dst[m].lo = *(const PG8_LAS v4i_t*)(lds + PG8_SA(b, h) + aoff + m * 2048); dst[m].hi = *(const PG8_LAS v4i_t*)(lds + PG8_SA(b, h) + aoff + m * 2048 + 1024); } } while (0)
#define PG8_LDB(dst, b, h) do { _Pragma("unroll") for (int n = 0; n < 2; ++n) { dst[n].lo = *(const PG8_LAS v4i_t*)(lds + PG8_SB(b, h) + boff + n * 2048); dst[n].hi = *(const PG8_LAS v4i_t*)(lds + PG8_SB(b, h) + boff + n * 2048 + 1024); } } while (0)
#define PG8_MMA(ai, bj, At, Bt) do { __builtin_amdgcn_s_setprio(1); _Pragma("unroll") for (int m = 0; m < 4; ++m) _Pragma("unroll") for (int n = 0; n < 2; ++n) { \
        if constexpr (F8) { if (F8_EXPERIMENT == 2) { _Pragma("unroll") for (int q = 0; q < 4; ++q) { \
                u32x4 bw, aw; _Pragma("unroll") for (int hh = 0; hh < 2; ++hh) { \
                    const auto b0 = __builtin_amdgcn_cvt_pk_f32_fp8(Bt[n][2 * q + hh], false), b1 = __builtin_amdgcn_cvt_pk_f32_fp8(Bt[n][2 * q + hh], true); \
                    const auto a0 = __builtin_amdgcn_cvt_pk_f32_fp8(At[m][2 * q + hh], false), a1 = __builtin_amdgcn_cvt_pk_f32_fp8(At[m][2 * q + hh], true); \
                    bw[2 * hh] = cvt_pk_bf16(b0[0], b0[1]); bw[2 * hh + 1] = cvt_pk_bf16(b1[0], b1[1]); aw[2 * hh] = cvt_pk_bf16(a0[0], a0[1]); aw[2 * hh + 1] = cvt_pk_bf16(a1[0], a1[1]); } \
                acc[ai][bj][m][n] = __builtin_amdgcn_mfma_f32_16x16x32_bf16(__builtin_bit_cast(bf16x8, bw), __builtin_bit_cast(bf16x8, aw), acc[ai][bj][m][n], 0, 0, 0); } } \
            else if (F8_EXPERIMENT == 1) { _Pragma("unroll") for (int q = 0; q < 4; ++q) { \
                const long bq = ((long)(unsigned)Bt[n][2 * q + 1] << 32) | (unsigned)Bt[n][2 * q], aq = ((long)(unsigned)At[m][2 * q + 1] << 32) | (unsigned)At[m][2 * q]; \
                acc[ai][bj][m][n] = __builtin_amdgcn_mfma_f32_16x16x32_fp8_fp8(bq, aq, acc[ai][bj][m][n], 0, 0, 0); } } \
            else asm volatile("v_mfma_f32_16x16x128_f8f6f4 %0, %1, %2, %0" : "+v"(acc[ai][bj][m][n]) : "v"(Bt[n]), "v"(At[m])); } \
        else { const v4i_t bl_ = Bt[n].lo, bh_ = Bt[n].hi, al_ = At[m].lo, ah_ = At[m].hi;     \
               acc[ai][bj][m][n] = __builtin_amdgcn_mfma_f32_16x16x32_bf16(__builtin_bit_cast(bf16x8, bl_), __builtin_bit_cast(bf16x8, al_), acc[ai][bj][m][n], 0, 0, 0); \
               acc[ai][bj][m][n] = __builtin_amdgcn_mfma_f32_16x16x32_bf16(__builtin_bit_cast(bf16x8, bh_), __builtin_bit_cast(bf16x8, ah_), acc[ai][bj][m][n], 0, 0, 0); } } \
        __builtin_amdgcn_s_setprio(0); } while (0)
#define PG8_WAIT_V(n) asm volatile("s_waitcnt vmcnt(" #n ")" ::: "memory")
#define PG8_WAIT_L(n) asm volatile("s_waitcnt lgkmcnt(" #n ")" ::: "memory")
#define PG8_BAR __builtin_amdgcn_s_barrier()
#define PG8_SCHED __builtin_amdgcn_sched_barrier(0)
    Unit cur, nxt; int ui = 0;
    if (!S.next(0, cur)) return;
    f32x4 acc[2][2][4][2];
#pragma unroll
    for (int a = 0; a < 2; ++a)
#pragma unroll
        for (int b = 0; b < 2; ++b)
#pragma unroll
            for (int m = 0; m < 4; ++m)
#pragma unroll
                for (int n = 0; n < 2; ++n) acc[a][b][m][n] = (f32x4){0.f, 0.f, 0.f, 0.f};
    v8i_t At[4], B0[2], B1[2];
    const PG8_LAS unsigned* rowtab = (const PG8_LAS unsigned*)(lds + STAGE_BYTES + 4096);
#define PG8_ROWTAB_FILL(u, par) do { if constexpr (GATHER) { if (wid < 4) __builtin_amdgcn_global_load_lds((const unsigned*)(g.arows + (u).pm * BM + wid * 64 + lane), (PG8_LAS unsigned*)(lds + STAGE_BYTES + 4096 + (par) * 1024 + wid * 256), 4, 0, 0); } } while (0)
    if constexpr (GATHER) { PG8_ROWTAB_FILL(cur, 0); PG8_WAIT_V(0); PG8_BAR; }
    const char* cA = GATHER ? (const char*)g.A : (const char*)g.A + (size_t)cur.pm * tstep; const char* cB = (const char*)g.Bt + (size_t)cur.pb * tstep;
    const char* cAs = SEG2 ? (const char*)g.A2 + (size_t)cur.pm * tstep2 : cA; const char* cBs = SEG2 ? (const char*)g.Bt2 + (size_t)cur.pb * tstep2 : cB;
    PG8_STAGE(PG8_SB(0, 0), cB, voffB); PG8_STAGE(PG8_SB(0, 1), cB + hstep, voffB); PG8_STAGE_A(PG8_SA(0, 0), cA, 0, 0); PG8_STAGE_A(PG8_SA(0, 1), cA, 1, 0);
    if (wr == 1) PG8_BAR;
    PG8_WAIT_V(2); PG8_BAR;
    PG8_STAGE(PG8_SB(1, 0), cB + kstep, voffB); PG8_STAGE_A(PG8_SA(1, 0), cA + kstep, 0, 0); PG8_STAGE(PG8_SB(1, 1), cB + hstep + kstep, voffB);
    PG8_WAIT_V(6); PG8_BAR;
    for (;;) {
        const bool has_next = S.next(ui + 1, nxt);
        const int parc = ui & 1;
        if (has_next) PG8_ROWTAB_FILL(nxt, parc ^ 1);
        const char* nA = GATHER ? (const char*)g.A : (has_next ? (const char*)g.A + (size_t)nxt.pm * tstep : cA); const char* nB = has_next ? (const char*)g.Bt + (size_t)nxt.pb * tstep : cB;
        for (int t = 0; t < nt; t += 2) {
            const bool last = (t == nt - 2);
            const bool c1 = SEG2 ? (t < nt1) : true, n1 = SEG2 ? (last || t + 2 < nt1) : true;
            const size_t hs_c = c1 ? hstep : hstep2, hs_n = n1 ? hstep : hstep2;
            unsigned vAc[2], vAn[2], vBn[2];
#pragma unroll
            for (int i = 0; i < 2; ++i) { vAc[i] = c1 ? voffA[i] : voffA2[i]; vAn[i] = n1 ? voffA[i] : voffA2[i]; vBn[i] = n1 ? voffB[i] : voffB2[i]; }
            const char* a1 = c1 ? cA + (size_t)(t + 1) * kstep : cAs + (size_t)(t + 1 - nt1) * kstep;
            const char* a2 = last ? nA : (n1 ? cA + (size_t)(t + 2) * kstep : cAs + (size_t)(t + 2 - nt1) * kstep); const char* b2 = last ? nB : (n1 ? cB + (size_t)(t + 2) * kstep : cBs + (size_t)(t + 2 - nt1) * kstep);
            const char* a3 = a2 + kstep; const char* b3 = b2 + kstep;
            if constexpr (SEG2) { if (t == nt1) { int fr_ = fr, fq_ = fq; asm volatile("" : "+v"(fr_), "+v"(fq_)); E.mid(acc, cur, wr, wc, fr_, fq_); } }
            const int par2 = (last && has_next) ? (parc ^ 1) : parc;
            PG8_LDB(B0, 0, 0); PG8_LDB(B1, 0, 1); PG8_SCHED; PG8_LDA(At, 0, 0); PG8_STAGE_AX(PG8_SA(1, 1), a1, 1, parc, hs_c, vAc);
            PG8_WAIT_V(8); PG8_WAIT_L(0); PG8_BAR; PG8_MMA(0, 0, At, B0); PG8_MMA(0, 1, At, B1); PG8_BAR; PG8_SCHED;
            PG8_LDA(At, 0, 1); PG8_STAGE(PG8_SB(0, 0), b2, vBn); PG8_STAGE(PG8_SB(0, 1), b2 + hs_n, vBn); PG8_STAGE_AX(PG8_SA(0, 0), a2, 0, par2, hs_n, vAn);
            PG8_WAIT_V(8); PG8_WAIT_L(0); PG8_BAR; PG8_MMA(1, 0, At, B0); PG8_MMA(1, 1, At, B1); PG8_BAR; PG8_SCHED;
            PG8_LDB(B0, 1, 0); PG8_LDB(B1, 1, 1); PG8_SCHED; PG8_LDA(At, 1, 0); PG8_STAGE_AX(PG8_SA(0, 1), a2, 1, par2, hs_n, vAn);
            PG8_WAIT_V(8); PG8_WAIT_L(0); PG8_BAR; PG8_MMA(0, 0, At, B0); PG8_MMA(0, 1, At, B1); PG8_BAR; PG8_SCHED;
            PG8_LDA(At, 1, 1); PG8_STAGE(PG8_SB(1, 0), b3, vBn); PG8_STAGE(PG8_SB(1, 1), b3 + hs_n, vBn); PG8_STAGE_AX(PG8_SA(1, 0), a3, 0, par2, hs_n, vAn);
            PG8_WAIT_V(8); PG8_WAIT_L(0); PG8_BAR; PG8_MMA(1, 0, At, B0); PG8_MMA(1, 1, At, B1); PG8_BAR; PG8_SCHED;
        }
        if (wr == 0) PG8_BAR;
        { int fr_ = fr, fq_ = fq; asm volatile("" : "+v"(fr_), "+v"(fq_)); E(acc, cur, wr, wc, fr_, fq_); }
        if (!has_next) break;
#pragma unroll
        for (int a = 0; a < 2; ++a)
#pragma unroll
            for (int b = 0; b < 2; ++b)
#pragma unroll
                for (int m = 0; m < 4; ++m)
#pragma unroll
                    for (int n = 0; n < 2; ++n) acc[a][b][m][n] = (f32x4){0.f, 0.f, 0.f, 0.f};
        cur = nxt; cA = nA; cB = nB; ++ui;
        if constexpr (SEG2) { cAs = (const char*)g.A2 + (size_t)cur.pm * tstep2; cBs = (const char*)g.Bt2 + (size_t)cur.pb * tstep2; }
        if (wr == 1) PG8_BAR;
    }
    PG8_WAIT_V(0);
    PG8_BAR;
#undef PG8_SA
#undef PG8_SB
#undef PG8_STAGE
#undef PG8_STAGE_A
#undef PG8_STAGE_AX
#undef PG8_LDA
#undef PG8_LDB
#undef PG8_MMA
#undef PG8_WAIT_V
#undef PG8_WAIT_L
#undef PG8_BAR
#undef PG8_SCHED
#undef PG8_ROWTAB_FILL
}

struct EpiInProj {
    unsigned char* pj; const float* biasp; const float* rc; const float* rs;
    __device__ __forceinline__ bf16_t* head_row(int pn, int hs, int b, int t) const {
        if (pn < 4) return (bf16_t*)(pj + PJ_QN) + ((size_t)(b * 8 + 2 * pn + hs) * S_ + t) * 128;
        if (pn < 10) return (bf16_t*)(pj + PJ_KV + (size_t)(pn - 4) * 16 * MiB) + ((size_t)(b * 2 + hs) * S_ + t) * 128;
        const int idx = pn - 10, cfg = idx / 6, part = (idx % 6) >> 1, half = idx & 1;
        return (bf16_t*)(pj + PJ_DIL + (size_t)(cfg * 3 + part) * 32 * MiB) + ((size_t)(b * 4 + 2 * half + hs) * S_ + dil_row(cfg, t)) * 128;
    }
    __device__ __forceinline__ void operator()(const f32x4 (&acc)[2][2][4][2], const Unit& u, int wr, int wc, int fr, int fq) const {
        const int pn = u.pn, pc = wc * 32 + fq * 8;
        const bool rope = is_rope_tile(pn), gate = pn >= 28;
        f32x4 bv[2][2];
#pragma unroll
        for (int bj = 0; bj < 2; ++bj)
#pragma unroll
            for (int n = 0; n < 2; ++n) bv[bj][n] = *(const f32x4*)(biasp + pn * 256 + bj * HALF + pc + 4 * n);
        if (rope) {
            const int hl = pc >> 6, d0 = pc & 63;
#pragma unroll
            for (int ai = 0; ai < 2; ++ai) {
                f32x4 C[4][2], S[4][2];
#pragma unroll
                for (int m = 0; m < 4; ++m) { const int t = (u.pm * BM + ai * HALF + wr * 64 + m * 16 + fr) & (S_ - 1);
#pragma unroll
                    for (int n = 0; n < 2; ++n) { C[m][n] = *(const f32x4*)(rc + t * 64 + d0 + 4 * n); S[m][n] = *(const f32x4*)(rs + t * 64 + d0 + 4 * n); } }
#pragma unroll
                for (int m = 0; m < 4; ++m) {
                    const int row = u.pm * BM + ai * HALF + wr * 64 + m * 16 + fr, t = row & (S_ - 1), b = row >> 12;
                    bf16_t* rowp = head_row(pn, hl, b, t) + d0;
                    u32x4 w1, w2;
#pragma unroll
                    for (int n = 0; n < 2; ++n) {
                        const f32x4 c = C[m][n], s = S[m][n];
                        const f32x4 x1 = acc[ai][0][m][n] + bv[0][n], x2 = acc[ai][1][m][n] + bv[1][n];
                        const f32x4 o1 = x1 * c - x2 * s, o2 = x2 * c + x1 * s;
                        w1[2 * n] = cvt_pk_bf16(o1[0], o1[1]); w1[2 * n + 1] = cvt_pk_bf16(o1[2], o1[3]);
                        w2[2 * n] = cvt_pk_bf16(o2[0], o2[1]); w2[2 * n + 1] = cvt_pk_bf16(o2[2], o2[3]);
                    }
                    *(u32x4*)rowp = w1; *(u32x4*)(rowp + 64) = w2;
                }
            }
        } else {
#pragma unroll
            for (int ai = 0; ai < 2; ++ai)
#pragma unroll
                for (int m = 0; m < 4; ++m) {
                    const int row = u.pm * BM + ai * HALF + wr * 64 + m * 16 + fr, t = row & (S_ - 1), b = row >> 12;
#pragma unroll
                    for (int bj = 0; bj < 2; ++bj) {
                        f32x4 v0 = acc[ai][bj][m][0] + bv[bj][0], v1 = acc[ai][bj][m][1] + bv[bj][1];
                        bf16_t* dst;
                        if (gate) {
#pragma unroll
                            for (int i = 0; i < 4; ++i) { v0[i] = sigm_fast(v0[i]); v1[i] = sigm_fast(v1[i]); }
                            if (pn < 36) dst = (bf16_t*)(pj + PJ_GA) + (size_t)row * DM + (pn - 28) * 256 + bj * HALF + pc;
                            else if (pn < 44) dst = (bf16_t*)(pj + PJ_GB) + (size_t)row * DM + (pn - 36) * 256 + bj * HALF + pc;
                            else dst = (bf16_t*)(pj + PJ_GL) + (size_t)row * 32 + pc;
                        } else dst = head_row(pn, bj, b, t) + pc;
                        u32x4 w; w.x = cvt_pk_bf16(v0[0], v0[1]); w.y = cvt_pk_bf16(v0[2], v0[3]); w.z = cvt_pk_bf16(v1[0], v1[1]); w.w = cvt_pk_bf16(v1[2], v1[3]);
                        if (pn < 44 || (bj == 0 && wc == 0)) *(u32x4*)dst = w;
                    }
                }
        }
    }
};
template <bool ACCUM> struct EpiBr {
    bf16_t* merged; const bf16_t* gbuf;
    __device__ __forceinline__ void operator()(const f32x4 (&acc)[2][2][4][2], const Unit& u, int wr, int wc, int fr, int fq) const {
        const int c0 = u.pn * BM + wc * 32 + fq * 8;
#pragma unroll
        for (int ai = 0; ai < 2; ++ai)
#pragma unroll
            for (int m = 0; m < 4; ++m) {
                const int row = u.pm * BM + ai * HALF + wr * 64 + m * 16 + fr;
#pragma unroll
                for (int bj = 0; bj < 2; ++bj) {
                    const u32x4 gw = *(const u32x4*)(gbuf + (size_t)row * DM + c0 + bj * HALF);
                    bf16_t* op = merged + (size_t)row * DM + c0 + bj * HALF;
                    u32x4 ow = {0u, 0u, 0u, 0u}; if (ACCUM) ow = *(const u32x4*)op;
                    u32x4 w;
#pragma unroll
                    for (int j = 0; j < 4; ++j) {
                        const f32x4& a = acc[ai][bj][m][j >> 1];
                        float v0 = __uint_as_float(gw[j] << 16) * a[(j & 1) * 2], v1 = __uint_as_float(gw[j] & 0xffff0000u) * a[(j & 1) * 2 + 1];
                        if (ACCUM) { v0 += __uint_as_float(ow[j] << 16); v1 += __uint_as_float(ow[j] & 0xffff0000u); }
                        w[j] = cvt_pk_bf16(v0, v1);
                    }
                    *(u32x4*)op = w;
                }
            }
    }
};
struct EpiBr2 {
    bf16_t* merged; const bf16_t* ga; const bf16_t* gb;
    __device__ __forceinline__ void mid(f32x4 (&acc)[2][2][4][2], const Unit& u, int wr, int wc, int fr, int fq) const {
        const int c0 = u.pn * BM + wc * 32 + fq * 8;
#pragma unroll
        for (int ai = 0; ai < 2; ++ai)
#pragma unroll
            for (int m = 0; m < 4; ++m) {
                const int row = u.pm * BM + ai * HALF + wr * 64 + m * 16 + fr;
#pragma unroll
                for (int bj = 0; bj < 2; ++bj) {
                    const u32x4 aw = *(const u32x4*)(ga + (size_t)row * DM + c0 + bj * HALF), bw = *(const u32x4*)(gb + (size_t)row * DM + c0 + bj * HALF);
#pragma unroll
                    for (int j = 0; j < 4; ++j) {
                        f32x4& a = acc[ai][bj][m][j >> 1];
                        a[(j & 1) * 2] *= __uint_as_float(aw[j] << 16) * __builtin_amdgcn_rcpf(fmaxf(__uint_as_float(bw[j] << 16), 1e-30f));
                        a[(j & 1) * 2 + 1] *= __uint_as_float(aw[j] & 0xffff0000u) * __builtin_amdgcn_rcpf(fmaxf(__uint_as_float(bw[j] & 0xffff0000u), 1e-30f));
                    }
                }
            }
    }
    __device__ __forceinline__ void operator()(const f32x4 (&acc)[2][2][4][2], const Unit& u, int wr, int wc, int fr, int fq) const {
        const int c0 = u.pn * BM + wc * 32 + fq * 8;
#pragma unroll
        for (int ai = 0; ai < 2; ++ai)
#pragma unroll
            for (int m = 0; m < 4; ++m) {
                const int row = u.pm * BM + ai * HALF + wr * 64 + m * 16 + fr;
#pragma unroll
                for (int bj = 0; bj < 2; ++bj) {
                    const u32x4 gw = *(const u32x4*)(gb + (size_t)row * DM + c0 + bj * HALF);
                    u32x4 w;
#pragma unroll
                    for (int j = 0; j < 4; ++j) {
                        const f32x4& a = acc[ai][bj][m][j >> 1];
                        w[j] = cvt_pk_bf16(__uint_as_float(gw[j] << 16) * a[(j & 1) * 2], __uint_as_float(gw[j] & 0xffff0000u) * a[(j & 1) * 2 + 1]);
                    }
                    *(u32x4*)(merged + (size_t)row * DM + c0 + bj * HALF) = w;
                }
            }
    }
};
struct EpiWout {
    bf16_t* u;
    __device__ __forceinline__ void operator()(const f32x4 (&acc)[2][2][4][2], const Unit& u_, int wr, int wc, int fr, int fq) const {
        const int c0 = u_.pn * BM + wc * 32 + fq * 8;
#pragma unroll
        for (int ai = 0; ai < 2; ++ai)
#pragma unroll
            for (int m = 0; m < 4; ++m) {
                const size_t off = (size_t)(u_.pm * BM + ai * HALF + wr * 64 + m * 16 + fr) * DM + c0;
#pragma unroll
                for (int bj = 0; bj < 2; ++bj) { const f32x4 v0 = acc[ai][bj][m][0], v1 = acc[ai][bj][m][1];
                    u32x4 w; w.x = cvt_pk_bf16(v0[0], v0[1]); w.y = cvt_pk_bf16(v0[2], v0[3]); w.z = cvt_pk_bf16(v1[0], v1[1]); w.w = cvt_pk_bf16(v1[2], v1[3]);
                    *(u32x4*)(u + off + bj * HALF) = w; }
            }
    }
};
struct EpiNull { __device__ __forceinline__ void operator()(const f32x4 (&acc)[2][2][4][2], const Unit& u, int wr, int wc, int fr, int fq) const {
    _Pragma("unroll") for (int a = 0; a < 2; ++a) _Pragma("unroll") for (int b = 0; b < 2; ++b) _Pragma("unroll") for (int m = 0; m < 4; ++m) _Pragma("unroll") for (int n = 0; n < 2; ++n) asm volatile("" :: "v"(acc[a][b][m][n])); } };
__device__ __forceinline__ unsigned f2e4m3(float v) {
    const unsigned s = (__float_as_uint(v) >> 24) & 0x80u;
    const float x = fminf(fabsf(v), 448.f);
    unsigned b = __float_as_uint(x); b += 0x7FFFFu + ((b >> 20) & 1u);
    const unsigned rn = (b >> 20) - 960u;
    const unsigned rs = (unsigned)__builtin_rintf(x * 512.f);
    return s | (x < 0.015625f ? rs : rn);
}
#ifndef SOFT_FP8
#define SOFT_FP8 0
#endif
__device__ __forceinline__ unsigned pk4_fp8(float a, float b, float c, float d) {
    if (SOFT_FP8) return f2e4m3(a) | (f2e4m3(b) << 8) | (f2e4m3(c) << 16) | (f2e4m3(d) << 24);
    int w = 0; w = __builtin_amdgcn_cvt_pk_fp8_f32(a, b, w, false); w = __builtin_amdgcn_cvt_pk_fp8_f32(c, d, w, true); return (unsigned)w; }
template <bool OUT8> struct EpiSwigluT {
    unsigned char* act; const float* bupp; float sc;
    __device__ __forceinline__ void operator()(const f32x4 (&acc)[2][2][4][2], const Unit& u, int wr, int wc, int fr, int fq) const {
        const int pc = wc * 32 + fq * 8, e = u.pb >> 4;
        const float* bp = bupp + e * 4096 + u.pn * 256 + pc;
        f32x4 bg[2], bl[2];
#pragma unroll
        for (int n = 0; n < 2; ++n) { bg[n] = *(const f32x4*)(bp + 4 * n); bl[n] = *(const f32x4*)(bp + HALF + 4 * n); }
#pragma unroll
        for (int ai = 0; ai < 2; ++ai)
#pragma unroll
            for (int m = 0; m < 4; ++m) {
                const int row = u.pm * BM + ai * HALF + wr * 64 + m * 16 + fr;
                float o[8];
#pragma unroll
                for (int n = 0; n < 2; ++n)
#pragma unroll
                    for (int i = 0; i < 4; ++i) {
                        float g = acc[ai][0][m][n][i] * sc + bg[n][i], l = acc[ai][1][m][n][i] * sc + bl[n][i];
                        g = fminf(g, 7.f); l = fminf(fmaxf(l, -7.f), 7.f);
                        o[4 * n + i] = g * sigm_fast(1.702f * g) * (l + 1.f);
                    }
                if constexpr (OUT8) { u32x2 w; w.x = pk4_fp8(o[0], o[1], o[2], o[3]); w.y = pk4_fp8(o[4], o[5], o[6], o[7]);
                    *(u32x2*)(act + (size_t)row * DM + u.pn * HALF + pc) = w; }
                else { u32x4 w; w.x = cvt_pk_bf16(o[0], o[1]); w.y = cvt_pk_bf16(o[2], o[3]); w.z = cvt_pk_bf16(o[4], o[5]); w.w = cvt_pk_bf16(o[6], o[7]);
                    *(u32x4*)((bf16_t*)act + (size_t)row * DM + u.pn * HALF + pc) = w; }
            }
    }
};
constexpr float Y8_SCALE = 16.f;
struct EpiDown {
    unsigned char* y; const float* bdn; const float* roww; float sc;
    __device__ __forceinline__ void operator()(const f32x4 (&acc)[2][2][4][2], const Unit& u, int wr, int wc, int fr, int fq) const {
        const int c0 = u.pn * BM + wc * 32 + fq * 8, e = u.pb >> 3;
        f32x4 bv[2][2];
#pragma unroll
        for (int bj = 0; bj < 2; ++bj)
#pragma unroll
            for (int n = 0; n < 2; ++n) bv[bj][n] = *(const f32x4*)(bdn + e * DM + c0 + bj * HALF + 4 * n);
#pragma unroll
        for (int ai = 0; ai < 2; ++ai)
#pragma unroll
            for (int m = 0; m < 4; ++m) {
                const int row = u.pm * BM + ai * HALF + wr * 64 + m * 16 + fr; const float rw = roww[row] * Y8_SCALE;
#pragma unroll
                for (int bj = 0; bj < 2; ++bj) {
                    const f32x4 v0 = (acc[ai][bj][m][0] * sc + bv[bj][0]) * rw, v1 = (acc[ai][bj][m][1] * sc + bv[bj][1]) * rw;
                    u32x2 w; w.x = pk4_fp8(v0[0], v0[1], v0[2], v0[3]); w.y = pk4_fp8(v1[0], v1[1], v1[2], v1[3]);
                    *(u32x2*)(y + (size_t)row * DM + c0 + bj * HALF) = w;
                }
            }
    }
};
}
#define XB_TMO      128
#define XB_XCNT(j)  (256  + 64 * (j))
#define XB_XSUB(j)  (1280 + 64 * (j))
#define XB_XGEN(j)  (2304 + 64 * (j))
#define XB_TOP      3328
#define XB_TOPGEN   3392
#define XCD_BAR_WORDS 3456
#define XB_SPIN_CAP (1u << 22)

__device__ __forceinline__ unsigned xb_ld(unsigned* p)              { return __hip_atomic_load(p, __ATOMIC_RELAXED, __HIP_MEMORY_SCOPE_AGENT); }
__device__ __forceinline__ unsigned xb_add(unsigned* p, unsigned v) { return __hip_atomic_fetch_add(p, v, __ATOMIC_RELAXED, __HIP_MEMORY_SCOPE_AGENT); }
__device__ __forceinline__ unsigned xb_xcc_id() { return (unsigned)__builtin_amdgcn_s_getreg((3 << 11) | 20) & 0xFu; }
#define XB_SPIN(cond, bar) do { unsigned _sp = 0; while (cond) { __builtin_amdgcn_s_sleep(1); \
    if ((++_sp & 255u) == 0u) { if (xb_ld(&(bar)[XB_TMO])) break; if (_sp > XB_SPIN_CAP) { atomicAdd(&(bar)[XB_TMO], 1u); break; } } } } while (0)

struct XcdBarrier {
    unsigned* bar; unsigned x;
    volatile LAS unsigned* st;
};
__device__ __forceinline__ XcdBarrier xcd_barrier_post(unsigned* bar, volatile LAS unsigned* st) {
    XcdBarrier b; b.bar = bar; b.x = xb_xcc_id(); b.st = st;
    if (threadIdx.x == 0) (void)xb_add(&bar[XB_XCNT(b.x)], 1u);
    return b;
}
__device__ __forceinline__ void xcd_barrier_complete(unsigned* bar, unsigned x, unsigned& nloc, unsigned& nx) {
    const unsigned G = gridDim.x * gridDim.y * gridDim.z;
    unsigned sum, cnt, mine, sp = 0u;
    for (;;) {
        sum = 0u; cnt = 0u; mine = 0u;
#pragma unroll
        for (unsigned j = 0; j < 16; ++j) { const unsigned c = xb_ld(&bar[XB_XCNT(j)]); sum += c; cnt += (c > 0u) ? 1u : 0u; mine = (j == x) ? c : mine; }
        if (sum == G) break;
        __builtin_amdgcn_s_sleep(1);
        if ((++sp & 255u) == 0u) { if (xb_ld(&bar[XB_TMO])) break; if (sp > XB_SPIN_CAP) { atomicAdd(&bar[XB_TMO], 1u); break; } }
    }
    nloc = mine > 0u ? mine : 1u; nx = cnt > 0u ? cnt : 1u;
}
__device__ __forceinline__ void xcd_barrier(const XcdBarrier& b, const bool leader  ) {
    asm volatile("s_waitcnt vmcnt(0)" ::: "memory");
    __syncthreads();
    if (leader) {
        unsigned* bar = b.bar;
        __builtin_amdgcn_s_waitcnt(0);
        unsigned nloc = b.st[0], nx = b.st[1];
        if (nloc == 0u) { xcd_barrier_complete(bar, b.x, nloc, nx); b.st[0] = nloc; b.st[1] = nx; }
        const unsigned old = xb_add(&bar[XB_XSUB(b.x)], 1u);
        const unsigned gen = old / nloc;
        if (old + 1u == (gen + 1u) * nloc) {
            __builtin_amdgcn_fence(__ATOMIC_RELEASE, "agent");
            asm volatile("s_waitcnt vmcnt(0)" ::: "memory");
            const unsigned og = xb_add(&bar[XB_TOP], 1u);
            const unsigned tg = og / nx;
            if (og + 1u == (tg + 1u) * nx) xb_add(&bar[XB_TOPGEN], 1u);
            else XB_SPIN(xb_ld(&bar[XB_TOPGEN]) == tg, bar);
            __builtin_amdgcn_fence(__ATOMIC_ACQUIRE, "agent");
            xb_add(&bar[XB_XGEN(b.x)], 1u);
            asm volatile("s_waitcnt vmcnt(0)" ::: "memory");
        } else {
            XB_SPIN(xb_ld(&bar[XB_XGEN(b.x)]) == gen, bar);
            __builtin_amdgcn_fence(__ATOMIC_ACQUIRE, "agent");
            asm volatile("s_waitcnt vmcnt(0)" ::: "memory");
        }
    }
    __syncthreads();
}
#ifndef PROBE_SUB
#define PROBE_SUB 0
#endif
constexpr int NWAVES = 8;
constexpr int RING_OFF = 0, RING_BYTES = 131072;
constexpr int SCR_WAVE_BYTES = 64 * 65 * 4;
constexpr int LDSCTL_OFF = 139264, MISC_OFF = LDSCTL_OFF + 320;
constexpr int LDS_BYTES = 147456;
static_assert(NWAVES * SCR_WAVE_BYTES <= LDSCTL_OFF && MISC_OFF + 128 <= LDS_BYTES, "LDS map");

struct Frame {
    LAS unsigned char* lds;
    volatile LAS unsigned* MISC;
    unsigned* ctl;
    int tid, lane, wave, vcu, G;
};

template <class ColFn>
__device__ __forceinline__ void transpose_item(const float* W, int ldw, int K, bf16_t* WT, int dst_row0, int k0, ColFn colfn, LAS float* scr, int lane) {
    const int ks = lane >> 4, n4 = lane & 15; const int sc = colfn(n4);
    f32x4 v[16];
#pragma unroll
    for (int i = 0; i < 16; ++i) v[i] = sc >= 0 ? *(const f32x4*)(W + (size_t)(k0 + 4 * i + ks) * ldw + sc) : (f32x4){0.f, 0.f, 0.f, 0.f};
#pragma unroll
    for (int i = 0; i < 16; ++i) {
        *(LAS f32x4*)(scr + (4 * i + ks) * 64 + ((n4 ^ (i >> 1)) << 2)) = v[i];
    }
    asm volatile("s_waitcnt lgkmcnt(0)" ::: "memory");
    const int nsub = lane >> 3, c = lane & 7;
#pragma unroll
    for (int q = 0; q < 8; ++q) {
        const int n = 8 * q + nsub; const LAS float* s = scr + (8 * c) * 64 + (n ^ (c << 2));
        u32x4 o; o.x = cvt_pk_bf16(s[0 * 64], s[1 * 64]); o.y = cvt_pk_bf16(s[2 * 64], s[3 * 64]); o.z = cvt_pk_bf16(s[4 * 64], s[5 * 64]); o.w = cvt_pk_bf16(s[6 * 64], s[7 * 64]);
        *(u32x4*)(WT + (size_t)(dst_row0 + n) * K + k0 + 8 * c) = o;
    }
    asm volatile("s_waitcnt lgkmcnt(0)" ::: "memory");
}

template <class ColFn>
__device__ __forceinline__ void transpose_item8(const float* W, int ldw, int K, unsigned char* WT, int dst_row0, int k0, ColFn colfn, LAS float* scr, int lane, float wscale) {
    const int ks = lane >> 4, n4 = lane & 15; const int sc = colfn(n4);
    f32x4 v[16];
#pragma unroll
    for (int i = 0; i < 16; ++i) v[i] = sc >= 0 ? *(const f32x4*)(W + (size_t)(k0 + 4 * i + ks) * ldw + sc) : (f32x4){0.f, 0.f, 0.f, 0.f};
#pragma unroll
    for (int i = 0; i < 16; ++i) {
        *(LAS f32x4*)(scr + (4 * i + ks) * 64 + ((n4 ^ (i >> 1)) << 2)) = v[i];
    }
    asm volatile("s_waitcnt lgkmcnt(0)" ::: "memory");
    const int nsub = lane >> 3, c = lane & 7;
#pragma unroll
    for (int q = 0; q < 8; ++q) {
        const int n = 8 * q + nsub; const LAS float* s = scr + (8 * c) * 64 + (n ^ (c << 2));
        u32x2 o; o.x = pg8::pk4_fp8(s[0 * 64] * wscale, s[1 * 64] * wscale, s[2 * 64] * wscale, s[3 * 64] * wscale); o.y = pg8::pk4_fp8(s[4 * 64] * wscale, s[5 * 64] * wscale, s[6 * 64] * wscale, s[7 * 64] * wscale);
        *(u32x2*)(WT + (size_t)(dst_row0 + n) * K + k0 + 8 * c) = o;
    }
    asm volatile("s_waitcnt lgkmcnt(0)" ::: "memory");
}
constexpr float W8_SCALE = 64.f;
struct MoeWItem { const float* src; unsigned char* dst; int ldw; };
__device__ __forceinline__ MoeWItem moe_w_decode(const Args& a, int idx, int wv, int lane) {
    unsigned char* ws = a.ws; const int ks = lane >> 4, n4 = lane & 15; MoeWItem it;
    if (idx < 8192) { const int e = idx >> 8, rem = idx & 255, grp = rem & 63, kb = (rem >> 6) * 8 + wv, r0 = grp * 64, pn = r0 >> 8, p0 = r0 & 255;
        const int sc0 = (p0 < 128 ? 128 * pn + p0 : 2048 + 128 * pn + p0 - 128) + 4 * n4;
        it.src = a.in[16] + (size_t)e * DM * 4096 + (size_t)(kb * 64 + ks) * 4096 + sc0; it.ldw = 4096; it.dst = (unsigned char*)(ws + WS_WUP) + (size_t)e * 4096 * DM + (size_t)r0 * DM + kb * 64; }
    else { const int i2 = idx - 8192, e = i2 >> 7, rem = i2 & 127, grp = rem & 31, kb = (rem >> 5) * 8 + wv, r0 = grp * 64;
        it.src = a.in[18] + (size_t)e * DM * DM + (size_t)(kb * 64 + ks) * DM + r0 + 4 * n4; it.ldw = DM; it.dst = (unsigned char*)(ws + WS_WDN) + (size_t)e * DM * DM + (size_t)r0 * DM + kb * 64; }
    return it;
}
__device__ __forceinline__ void moe_w_load(f32x4 (&v)[16], const MoeWItem& it) {
#pragma unroll
    for (int i = 0; i < 16; ++i) v[i] = *(const f32x4*)(it.src + (size_t)(4 * i) * it.ldw);
}
__device__ __forceinline__ void moe_w_to_lds(const f32x4 (&v)[16], LAS float* scr, int lane) {
    const int ks = lane >> 4, n4 = lane & 15;
#pragma unroll
    for (int i = 0; i < 16; ++i) *(LAS f32x4*)(scr + (4 * i + ks) * 64 + ((n4 ^ (i >> 1)) << 2)) = v[i];
    asm volatile("s_waitcnt lgkmcnt(0)" ::: "memory");
}
__device__ __forceinline__ void moe_w_from_lds(const MoeWItem& it, LAS float* scr, int lane) {
    const int nsub = lane >> 3, c = lane & 7;
#pragma unroll
    for (int q = 0; q < 8; ++q) {
        const int n = 8 * q + nsub; const LAS float* s = scr + (8 * c) * 64 + (n ^ (c << 2));
        u32x2 o; o.x = pg8::pk4_fp8(s[0 * 64] * W8_SCALE, s[1 * 64] * W8_SCALE, s[2 * 64] * W8_SCALE, s[3 * 64] * W8_SCALE); o.y = pg8::pk4_fp8(s[4 * 64] * W8_SCALE, s[5 * 64] * W8_SCALE, s[6 * 64] * W8_SCALE, s[7 * 64] * W8_SCALE);
        *(u32x2*)(it.dst + (size_t)n * DM + 8 * c) = o;
    }
    asm volatile("s_waitcnt lgkmcnt(0)" ::: "memory");
}
__device__ __forceinline__ void moe_w_batch(const Args& a, int i0, int i1, LAS float* scr, int wv, int lane) {
    if (i0 >= i1) return;
    f32x4 v[16];
    MoeWItem cur = moe_w_decode(a, i0, wv, lane);
    moe_w_load(v, cur);
#pragma unroll 1
    for (int i = i0; i < i1; ++i) {
        moe_w_to_lds(v, scr, lane);
        MoeWItem nxt = cur;
        if (i + 1 < i1) { nxt = moe_w_decode(a, i + 1, wv, lane); moe_w_load(v, nxt); }
        moe_w_from_lds(cur, scr, lane);
        cur = nxt;
    }
}
constexpr int MOE_W_ITEMS = 8192 + 4096, MOE_W_BATCH = 8;
__device__ __forceinline__ void p0_prologue(Frame& F, const Args& a) {
    unsigned char* ws = a.ws;
    LAS float* scr = (LAS float*)(F.lds + F.wave * SCR_WAVE_BYTES);
    const int gw = F.vcu * NWAVES + F.wave, NGW = F.G * NWAVES, gt = gw * 64 + F.lane, NGT = NGW * 64;
    { float* rc = (float*)(ws + WS_ROPE); float* rs = rc + 4096 * 64;
      for (int i = gt; i < 4096 * 64; i += NGT) { const int t = i >> 6, j = i & 63; const float inv = powf(10000.f, -(float)(2 * j) / 128.f); const float ang = (float)t * inv; float sn, cs; sincosf(ang, &sn, &cs); rc[i] = cs; rs[i] = sn; }
      int* rowtok = (int*)(ws + WS_ROUTE + 4 * 512 * 1024); float* roww = (float*)(ws + WS_ROUTE + 4 * 512 * 1024 + 544 * 1024);
      for (int i = gt; i < MOE_ROWS; i += NGT) { rowtok[i] = 0; roww[i] = 0.f; }
      float* binp = (float*)(ws + WS_BINP); const float* b_in = a.in[2];
      for (int i = gt; i < LDP; i += NGT) { const int pn = i >> 8, wc = wcol_of(pn * 256 + inproj_phys2log(pn, i & 255)); binp[i] = wc >= 0 ? b_in[wc] : 0.f; }
      { const float* wr_ = a.in[14]; bf16_t* wrh = (bf16_t*)(ws + WS_WRT); bf16_t* wrl = wrh + 32 * 2048;
        for (int i = gt; i < 32 * 2048; i += NGT) { const int e = i >> 11, k = i & 2047; const float w = wr_[k * 32 + e]; const unsigned hb_ = cvt_pk_bf16(w, 0.f) & 0xffffu;
            wrh[i] = (bf16_t)hb_; wrl[i] = (bf16_t)(cvt_pk_bf16(w - __uint_as_float(hb_ << 16), 0.f) & 0xffffu); } }
      float* bupp = (float*)(ws + WS_BUPP); const float* b_up = a.in[17];
      for (int i = gt; i < NEXP * 4096; i += NGT) { const int e = i >> 12, n = i & 4095, pn = n >> 8, p = n & 255; bupp[i] = b_up[e * 4096 + (p < 128 ? 128 * pn + p : 2048 + 128 * pn + p - 128)]; }
    }
    if (gw < 128) { const int which = gw >> 6, chunk = (gw >> 2) & 15, n = (gw & 3) * 64 + F.lane; const float* pos = a.in[3 + which] + chunk * 256; const float* w1 = a.in[which ? 7 : 5] + (size_t)chunk * 256 * 256; float acc = 0.f;
#pragma unroll 16
        for (int k = 0; k < 256; ++k) acc += pos[k] * w1[(size_t)k * 256 + n];
        ((float*)(ws + WS_POSB))[(which * 16 + chunk) * 256 + n] = acc; }
    { const float* x = a.in[0]; bf16_t* xb = (bf16_t*)(ws + WS_XB); const float* w_in = a.in[1]; const float* b_in = a.in[2];
      constexpr int GLP = 4112;
      for (int idx = F.tid; idx < 2048 * 8; idx += NWAVES * 64) { const int k = idx >> 3, q = idx & 7;
          f32x4 w = {0.f, 0.f, 0.f, 0.f}; if (q < 6) w = *(const f32x4*)(w_in + (size_t)k * IN_W + 2560 + 4 * q);
#pragma unroll
          for (int i = 0; i < 4; ++i) *(LAS unsigned short*)(F.lds + (4 * q + i) * GLP + k * 2) = (unsigned short)(cvt_pk_bf16(w[i], 0.f) & 0xffffu); }
      __syncthreads();
      const int i = F.lane & 15, kq = F.lane >> 4;
      bf16_t* gl = (bf16_t*)(ws + WS_PROJ + PJ_GL);
      const float bias0 = b_in[2560 + i], bias1 = i < 8 ? b_in[2560 + 16 + i] : 0.f;
      for (int grp = gw; grp < T_ / 16; grp += NGW) {
          const int r0 = grp * 16;
          const float* xr = x + (size_t)(r0 + i) * DM + 4 * kq; bf16_t* xo = xb + (size_t)(r0 + i) * DM + 4 * kq;
          const LAS unsigned char* bp = F.lds + i * GLP + kq * 8;
          f32x4 acc0 = {0.f, 0.f, 0.f, 0.f}, acc1 = {0.f, 0.f, 0.f, 0.f};
#pragma unroll 1
          for (int sb = 0; sb < 64; sb += 8) {
              f32x4 xa[8], xc[8];
#pragma unroll
              for (int u = 0; u < 8; ++u) { xa[u] = *(const f32x4*)(xr + 32 * (sb + u)); xc[u] = *(const f32x4*)(xr + 32 * (sb + u) + 16); }
#pragma unroll
              for (int u = 0; u < 8; ++u) { const int s2 = sb + u;
                  u32x4 pk; pk.x = cvt_pk_bf16(xa[u][0], xa[u][1]); pk.y = cvt_pk_bf16(xa[u][2], xa[u][3]); pk.z = cvt_pk_bf16(xc[u][0], xc[u][1]); pk.w = cvt_pk_bf16(xc[u][2], xc[u][3]);
                  { u32x2 lo_; lo_.x = pk.x; lo_.y = pk.y; u32x2 hi_; hi_.x = pk.z; hi_.y = pk.w; *(u32x2*)(xo + 32 * s2) = lo_; *(u32x2*)(xo + 32 * s2 + 16) = hi_; }
                  u32x4 b0, b1; { const u32x2 p0 = *(const LAS u32x2*)(bp + s2 * 64), p1 = *(const LAS u32x2*)(bp + s2 * 64 + 32), q0 = *(const LAS u32x2*)(bp + 16 * GLP + s2 * 64), q1 = *(const LAS u32x2*)(bp + 16 * GLP + s2 * 64 + 32); b0.x = p0.x; b0.y = p0.y; b0.z = p1.x; b0.w = p1.y; b1.x = q0.x; b1.y = q0.y; b1.z = q1.x; b1.w = q1.y; }
                  acc0 = __builtin_amdgcn_mfma_f32_16x16x32_bf16(__builtin_bit_cast(bf16x8, pk), __builtin_bit_cast(bf16x8, b0), acc0, 0, 0, 0);
                  acc1 = __builtin_amdgcn_mfma_f32_16x16x32_bf16(__builtin_bit_cast(bf16x8, pk), __builtin_bit_cast(bf16x8, b1), acc1, 0, 0, 0); }
          }
#pragma unroll
          for (int r = 0; r < 4; ++r) { const size_t tok = (size_t)(r0 + 4 * kq + r);
              gl[tok * 32 + i] = (bf16_t)(cvt_pk_bf16(sigm_fast(acc0[r] + bias0), 0.f) & 0xffffu);
              gl[tok * 32 + 16 + i] = (bf16_t)(cvt_pk_bf16(sigm_fast(acc1[r] + bias1), 0.f) & 0xffffu); }
      }
      __syncthreads();
    }
    const int wg = F.vcu, NWG = F.G, wv = F.wave;
#define TR_LOOP8(nmat, ngrp, nk, W_OF, LDW, KK, WT_OF, ROW0_OF, COLFN) \
    for (int wi = wg; wi < (nmat) * (ngrp) * (((nk) + 7) / 8); wi += NWG) { \
        const int per = (ngrp) * (((nk) + 7) / 8), e = wi / per, rem = wi - e * per, grp = rem % (ngrp), kb = (rem / (ngrp)) * 8 + wv; \
        if (kb < (nk)) { const int r0 = (ROW0_OF); transpose_item8((W_OF), (LDW), (KK), (WT_OF), r0, kb * 64, COLFN, scr, F.lane, W8_SCALE); } }
#define TR_LOOP(OFF, nmat, ngrp, nk, W_OF, LDW, KK, WT_OF, ROW0_OF, COLFN) \
    for (int wi = (wg + NWG - ((OFF) % NWG)) % NWG; wi < (nmat) * (ngrp) * (((nk) + 7) / 8); wi += NWG) {        \
        const int per = (ngrp) * (((nk) + 7) / 8), e = wi / per, rem = wi - e * per, grp = rem % (ngrp), kb = (rem / (ngrp)) * 8 + wv; \
        if (kb < (nk)) { const int r0 = (ROW0_OF); transpose_item((W_OF), (LDW), (KK), (WT_OF), r0, kb * 64, COLFN, scr, F.lane); } }
    TR_LOOP(0, 1, 176, 32, a.in[1], IN_W, DM, (bf16_t*)(ws + WS_WIN), grp * 64, ([&](int n4) { const int pn = r0 >> 8; return wcol_of(pn * 256 + inproj_phys2log(pn, (r0 & 255) + 4 * n4)); }))
    TR_LOOP(704, 1, 32, 16, a.in[9], DM, 1024, (bf16_t*)(ws + WS_WBA), grp * 64, ([&](int n4) { return r0 + 4 * n4; }))
    TR_LOOP(768, 1, 32, 8, a.in[10], DM, 512, (bf16_t*)(ws + WS_WBD), grp * 64, ([&](int n4) { return r0 + 4 * n4; }))
    TR_LOOP(800, 1, 32, 32, a.in[11], DM, DM, (bf16_t*)(ws + WS_WOUT), grp * 64, ([&](int n4) { return r0 + 4 * n4; }))
    TR_LOOP(928, 2, 4, 64, a.in[e ? 7 : 5], 256, 4096, (bf16_t*)(ws + WS_CW1) + (size_t)e * 256 * 4096, grp * 64, ([&](int n4) { return r0 + 4 * n4; }))
    TR_LOOP(992, 2, 2, 4, a.in[e ? 8 : 6], 128, 256, (bf16_t*)(ws + WS_CW2) + (size_t)e * 128 * 256, grp * 64, ([&](int n4) { return r0 + 4 * n4; }))
#undef TR_LOOP
#undef TR_LOOP8
}
__device__ __forceinline__ void p_ln1_router(Frame& F, const Args& a) {
    unsigned char* ws = a.ws;
    const float* g = a.in[12]; const float* bb = a.in[13]; const float* wr = a.in[14]; const float* br = a.in[15];
    unsigned* ctl = F.ctl;
    int* topi = (int*)(ws + WS_ROUTE); float* topw = (float*)(ws + WS_ROUTE + 512 * 1024); int* pos = (int*)(ws + WS_ROUTE + 2 * 512 * 1024);
    const int gw = F.vcu * NWAVES + F.wave, NGW = F.G * NWAVES, lane = F.lane;
    LAS float* lt = (LAS float*)(F.lds) + F.wave * (16 * 33);
    f32x4 GV1[8], BV1[8];
#pragma unroll
    for (int j = 0; j < 4; ++j)
#pragma unroll
        for (int hlf = 0; hlf < 2; ++hlf) { GV1[2 * j + hlf] = *(const f32x4*)(g + (lane + 64 * j) * 8 + 4 * hlf); BV1[2 * j + hlf] = *(const f32x4*)(bb + (lane + 64 * j) * 8 + 4 * hlf); }
#pragma unroll
    for (int j = 0; j < 8; ++j) asm volatile("" : "+v"(GV1[j]), "+v"(BV1[j]));
    const bool agg = ((T_ / 16) % NGW) == 0;
    LAS unsigned* lcnt = (LAS unsigned*)(F.lds + 20480); LAS unsigned* lbase = lcnt + 32;
    if (agg) { if (F.tid < 32) lcnt[F.tid] = 0u; __syncthreads(); }
    for (int grp = gw; grp < T_ / 16; grp += NGW) {
        const int tok0 = grp * 16;
        const float* x = a.in[0]; const bf16_t* ub = (const bf16_t*)(ws + WS_Z);
        f32x4 xn[8]; u32x4 un[4];
#pragma unroll
        for (int j = 0; j < 4; ++j) { const size_t o = (size_t)tok0 * DM + (lane + 64 * j) * 8; xn[2 * j] = *(const f32x4*)(x + o); xn[2 * j + 1] = *(const f32x4*)(x + o + 4); un[j] = *(const u32x4*)(ub + o); }
#pragma unroll 1
        for (int ti = 0; ti < 16; ++ti) {
            const int tok = tok0 + ti;
            bf16_t* hh = (bf16_t*)(ws + WS_H) + (size_t)tok * DM; bf16_t* hl = hh + (size_t)T_ * DM; unsigned char* hb = (unsigned char*)(ws + WS_HB) + (size_t)tok * DM;
            float v[32]; float s = 0.f;
#pragma unroll
            for (int j = 0; j < 4; ++j)
#pragma unroll
                for (int i = 0; i < 8; ++i) { const unsigned w = un[j][i >> 1]; const float uu = __uint_as_float((i & 1) ? (w & 0xffff0000u) : (w << 16)); const float t = DN_ALPHA * xn[2 * j + (i >> 2)][i & 3] + uu; v[8 * j + i] = t; s += t; }
            { const size_t o1 = (size_t)(tok + (ti < 15 ? 1 : 0)) * DM;
#pragma unroll
              for (int j = 0; j < 4; ++j) { const size_t o = o1 + (lane + 64 * j) * 8; xn[2 * j] = *(const f32x4*)(x + o); xn[2 * j + 1] = *(const f32x4*)(x + o + 4); un[j] = *(const u32x4*)(ub + o); } }
            const float mean = wave_sum(s) * (1.f / DM); float q = 0.f;
#pragma unroll
            for (int i = 0; i < 32; ++i) { v[i] -= mean; q += v[i] * v[i]; }
            const float rstd = rsqrtf(wave_sum(q) * (1.f / DM) + LN_EPS);
#pragma unroll
            for (int j = 0; j < 4; ++j) {
                const int k0 = (lane + 64 * j) * 8;
                float hv[8];
#pragma unroll
                for (int hlf = 0; hlf < 2; ++hlf) { const f32x4 gv = GV1[2 * j + hlf], bv = BV1[2 * j + hlf];
#pragma unroll
                    for (int i = 0; i < 4; ++i) hv[4 * hlf + i] = v[8 * j + 4 * hlf + i] * rstd * gv[i] + bv[i]; }
                { u32x4 wh, wl;
#pragma unroll
                  for (int i = 0; i < 4; ++i) { const unsigned ph = cvt_pk_bf16(hv[2 * i], hv[2 * i + 1]); wh[i] = ph;
                      wl[i] = cvt_pk_bf16(hv[2 * i] - __uint_as_float(ph << 16), hv[2 * i + 1] - __uint_as_float(ph & 0xffff0000u)); }
                  *(u32x4*)(hh + k0) = wh; *(u32x4*)(hl + k0) = wl; }
                u32x2 w8; w8.x = pg8::pk4_fp8(hv[0], hv[1], hv[2], hv[3]); w8.y = pg8::pk4_fp8(hv[4], hv[5], hv[6], hv[7]);
                *(u32x2*)(hb + k0) = w8;
            }
        }
        asm volatile("s_waitcnt vmcnt(0)" ::: "memory");
        { const int i = lane & 15, kq = lane >> 4;
          const bf16_t* ah = (const bf16_t*)(ws + WS_H) + (size_t)(tok0 + i) * DM + kq * 8; const bf16_t* al = ah + (size_t)T_ * DM;
          const bf16_t* bh0 = (const bf16_t*)(ws + WS_WRT) + (size_t)i * 2048 + kq * 8; const bf16_t* bl0 = bh0 + 32 * 2048;
          f32x4 acc0 = {0.f, 0.f, 0.f, 0.f}, acc1 = {0.f, 0.f, 0.f, 0.f};
#pragma unroll 4
          for (int s2 = 0; s2 < 64; ++s2) {
              const bf16x8 xh = *(const bf16x8*)(ah + 32 * s2), xl = *(const bf16x8*)(al + 32 * s2);
              const bf16x8 wh0 = *(const bf16x8*)(bh0 + 32 * s2), wl0 = *(const bf16x8*)(bl0 + 32 * s2), wh1 = *(const bf16x8*)(bh0 + 16 * 2048 + 32 * s2), wl1 = *(const bf16x8*)(bl0 + 16 * 2048 + 32 * s2);
              acc0 = __builtin_amdgcn_mfma_f32_16x16x32_bf16(xh, wl0, acc0, 0, 0, 0); acc0 = __builtin_amdgcn_mfma_f32_16x16x32_bf16(xl, wh0, acc0, 0, 0, 0); acc0 = __builtin_amdgcn_mfma_f32_16x16x32_bf16(xh, wh0, acc0, 0, 0, 0);
              acc1 = __builtin_amdgcn_mfma_f32_16x16x32_bf16(xh, wl1, acc1, 0, 0, 0); acc1 = __builtin_amdgcn_mfma_f32_16x16x32_bf16(xl, wh1, acc1, 0, 0, 0); acc1 = __builtin_amdgcn_mfma_f32_16x16x32_bf16(xh, wh1, acc1, 0, 0, 0);
          }
#pragma unroll
          for (int r = 0; r < 4; ++r) { lt[(4 * kq + r) * 33 + i] = acc0[r]; lt[(4 * kq + r) * 33 + 16 + i] = acc1[r]; }
        }
        asm volatile("s_waitcnt lgkmcnt(0)" ::: "memory");
        int idx[4] = {0, 0, 0, 0}; unsigned lp[4] = {0u, 0u, 0u, 0u};
        if (lane < 16) {
            const int tok = tok0 + lane;
            float lg[32];
#pragma unroll
            for (int e = 0; e < 32; ++e) lg[e] = lt[lane * 33 + e] + br[e];
            float val[4];
#pragma unroll
            for (int k = 0; k < 4; ++k) { float best = -INFINITY; int bi = 0;
#pragma unroll
                for (int e = 0; e < 32; ++e) { bool taken = false;
#pragma unroll
                    for (int kk = 0; kk < k; ++kk) taken |= (idx[kk] == e);
                    if (!taken && lg[e] > best) { best = lg[e]; bi = e; } }
                idx[k] = bi; val[k] = best; }
            const float e1 = expf(val[1] - val[0]), e2 = expf(val[2] - val[0]), e3 = expf(val[3] - val[0]), den = 1.f + e1 + e2 + e3;
            const float w4[4] = {1.f / den, e1 / den, e2 / den, e3 / den};
#pragma unroll
            for (int k = 0; k < 4; ++k) { const int e = idx[k]; topi[tok * 4 + k] = e; topw[tok * 4 + k] = w4[k];
                if (agg) lp[k] = __hip_atomic_fetch_add(lcnt + e, 1u, __ATOMIC_RELAXED, __HIP_MEMORY_SCOPE_WORKGROUP);
                else pos[tok * 4 + k] = (int)atomicAdd(&ctl[CW_CNT + e], 1u); }
        }
        if (agg) {
            __syncthreads();
            if (F.tid < 32) { const unsigned c_ = lcnt[F.tid]; lbase[F.tid] = c_ ? atomicAdd(&ctl[CW_CNT + F.tid], c_) : 0u; lcnt[F.tid] = 0u; }
            __syncthreads();
            if (lane < 16) { const int tok = tok0 + lane;
#pragma unroll
                for (int k = 0; k < 4; ++k) pos[tok * 4 + k] = (int)(lbase[idx[k]] + lp[k]); }
            __syncthreads();
        }
        asm volatile("s_waitcnt lgkmcnt(0)" ::: "memory");
    }
}
__device__ __forceinline__ void p_scatter(Frame& F, const Args& a) {
    unsigned char* ws = a.ws; unsigned* ctl = F.ctl;
    LAS unsigned* pst = (LAS unsigned*)(F.lds);
    if (F.tid == 0) { unsigned acc = 0; for (int e = 0; e < 32; ++e) { pst[e] = acc; acc += ((ctl[CW_CNT + e] + 255u) >> 8) << 8; } pst[32] = acc; }
    __syncthreads();
    if (blockIdx.x == 0) {
        if (F.tid < 32) { const unsigned s0 = pst[F.tid] >> 8, s1 = pst[F.tid + 1] >> 8; for (unsigned t = s0; t < s1; ++t) ctl[CW_TILEEXP + t] = (unsigned)F.tid; }
        if (F.tid == 0) ctl[CW_NTILES] = pst[32] >> 8;
    }
    const int* topi = (const int*)(ws + WS_ROUTE); const float* topw = (const float*)(ws + WS_ROUTE + 512 * 1024); const int* pos = (const int*)(ws + WS_ROUTE + 2 * 512 * 1024);
    int* dest = (int*)(ws + WS_ROUTE + 3 * 512 * 1024);
    int* rowtok = (int*)(ws + WS_ROUTE + 4 * 512 * 1024); float* roww = (float*)(ws + WS_ROUTE + 4 * 512 * 1024 + 544 * 1024);
    for (int i = blockIdx.x * (NWAVES * 64) + F.tid; i < T_ * 4; i += F.G * NWAVES * 64) { const int d = (int)pst[topi[i]] + pos[i]; dest[i] = d; rowtok[d] = i >> 2; roww[d] = topw[i]; }
    __syncthreads();
}
__device__ __forceinline__ void p_final(Frame& F, const Args& a) {
    unsigned char* ws = a.ws;
    const unsigned char* y = (const unsigned char*)(ws + WS_Y);
    typedef int i32x4 __attribute__((ext_vector_type(4)));
    const i32x4* dest4 = (const i32x4*)(ws + WS_ROUTE + 3 * 512 * 1024);
    const float* g = a.in[20]; const float* bb = a.in[21];
    const int gw = F.vcu * NWAVES + F.wave, NGW = F.G * NWAVES, lane = F.lane;
    LAS unsigned char* buf = F.lds + F.wave * 16384;
#define FIN_DMA(tok_, dk_) do { const unsigned char* hs_ = (const unsigned char*)(ws + WS_H) + (size_t)(tok_) * (DM * 2) + lane * 16;        \
        _Pragma("unroll") for (int q = 0; q < 4; ++q) __builtin_amdgcn_global_load_lds((const unsigned*)(hs_ + q * 1024), (LAS unsigned*)(buf + q * 1024), 16, 0, 0); \
        _Pragma("unroll") for (int k = 0; k < 4; ++k) { const unsigned char* ys_ = y + (size_t)dk_[k] * DM + lane * 16; \
            _Pragma("unroll") for (int q = 0; q < 2; ++q) __builtin_amdgcn_global_load_lds((const unsigned*)(ys_ + q * 1024), (LAS unsigned*)(buf + 8192 + k * 2048 + q * 1024), 16, 0, 0); } } while (0)
    int tok = gw; if (tok >= T_) return;
    f32x4 GV[8], BV[8];
#pragma unroll
    for (int j = 0; j < 4; ++j)
#pragma unroll
        for (int hlf = 0; hlf < 2; ++hlf) { GV[2 * j + hlf] = *(const f32x4*)(g + (lane + 64 * j) * 8 + 4 * hlf); BV[2 * j + hlf] = *(const f32x4*)(bb + (lane + 64 * j) * 8 + 4 * hlf); }
#pragma unroll
    for (int j = 0; j < 8; ++j) asm volatile("" : "+v"(GV[j]), "+v"(BV[j]));
    i32x4 d1 = dest4[tok + NGW < T_ ? tok + NGW : tok];
    { const i32x4 d0 = dest4[tok]; FIN_DMA(tok, d0); }
    asm volatile("s_waitcnt vmcnt(0)" ::: "memory");
#pragma unroll 1
    for (;;) {
        const int tok1 = tok + NGW, tok2 = tok + 2 * NGW;
        u32x4 H[4]; u32x2 Y[16];
#pragma unroll
        for (int j = 0; j < 4; ++j) { H[j] = *(const LAS u32x4*)(buf + (lane + 64 * j) * 16);
#pragma unroll
            for (int k = 0; k < 4; ++k) Y[4 * j + k] = *(const LAS u32x2*)(buf + 8192 + k * 2048 + (lane + 64 * j) * 8); }
        asm volatile("s_waitcnt lgkmcnt(0)" ::: "memory");
        const i32x4 d2 = dest4[tok2 < T_ ? tok2 : tok];
        if (tok1 < T_) FIN_DMA(tok1, d1);
        float v[32]; float s = 0.f;
#pragma unroll
        for (int j = 0; j < 4; ++j) { float f[8] = {0.f, 0.f, 0.f, 0.f, 0.f, 0.f, 0.f, 0.f};
#pragma unroll
            for (int k = 0; k < 4; ++k)
#pragma unroll
                for (int i = 0; i < 2; ++i) { const auto lo = __builtin_amdgcn_cvt_pk_f32_fp8((int)Y[4 * j + k][i], false), hi2 = __builtin_amdgcn_cvt_pk_f32_fp8((int)Y[4 * j + k][i], true);
                    f[4 * i] += lo[0]; f[4 * i + 1] += lo[1]; f[4 * i + 2] += hi2[0]; f[4 * i + 3] += hi2[1]; }
#pragma unroll
            for (int i = 0; i < 8; ++i) { const unsigned hw_ = H[j][i >> 1]; const float hv_ = __uint_as_float((i & 1) ? (hw_ & 0xffff0000u) : (hw_ << 16));
                const float t = DN_ALPHA * hv_ + f[i] * (1.f / pg8::Y8_SCALE); v[8 * j + i] = t; s += t; } }
        const float mean = wave_sum(s) * (1.f / DM); float q2 = 0.f;
#pragma unroll
        for (int i = 0; i < 32; ++i) { v[i] -= mean; q2 += v[i] * v[i]; }
        const float rstd = rsqrtf(wave_sum(q2) * (1.f / DM) + LN_EPS);
#pragma unroll
        for (int j = 0; j < 4; ++j) { const int c = (lane + 64 * j) * 8;
#pragma unroll
            for (int hlf = 0; hlf < 2; ++hlf) { const f32x4 gv = GV[2 * j + hlf], bv = BV[2 * j + hlf]; f32x4 o;
#pragma unroll
                for (int i = 0; i < 4; ++i) o[i] = v[8 * j + 4 * hlf + i] * rstd * gv[i] + bv[i];
                *(f32x4*)(a.out + (size_t)tok * DM + c + 4 * hlf) = o; } }
        if (tok1 >= T_) break;
        asm volatile("s_waitcnt vmcnt(8)" ::: "memory");
        tok = tok1; d1 = d2;
    }
    asm volatile("s_waitcnt vmcnt(0)" ::: "memory");
#undef FIN_DMA
}
namespace fa {
typedef short s16x4 __attribute__((ext_vector_type(4)));
constexpr int SHM_V = 16384, SHM_K = 16384;
constexpr int L_V = 0, L_K = 2 * SHM_V, L_WS = L_K + 2 * SHM_K, L_IMP = L_WS + 2048, L_SELM = L_IMP + 65536, L_MISC = L_SELM + 512, L_END = L_MISC + 64;
static_assert(L_END <= LDSCTL_OFF, "attention LDS map");
constexpr int kb_off(int b) { return b < 2 ? L_K + b * SHM_K : L_IMP; }
constexpr int vb_off(int b) { return b < 2 ? L_V + b * SHM_V : L_IMP + SHM_K; }
constexpr float SCALE = ATT_SCALE, C2 = 1.4426950408889634f * ATT_SCALE, THR = 8.f;
#define KSWZ(row, colB) ((row) * 256 + ((colB) ^ (((row) & 7) << 4)))
#define SBAR() __builtin_amdgcn_sched_barrier(0)
__device__ __forceinline__ int v_st(int k, int c) { const int kk = (k & ~0xC) | ((k & 4) << 1) | ((k & 8) >> 1); return ((kk >> 3) * 4 + (c >> 5)) * 512 + ((kk & 7) * 32 + (c & 31)) * 2; }
__device__ __forceinline__ int v_rd_base(int lane) { return ((lane & 3) << 3) | (((lane >> 2) & 3) << 6) | (((lane >> 4) & 1) << 5) | (((lane >> 5) & 1) << 8); }
constexpr int v_rd_off(int d0, int ks, int half) { return d0 * 512 + ks * 4096 + half * 2048; }
__device__ __forceinline__ int crow(int r, int hi) { return (r & 3) + 8 * (r >> 2) + 4 * hi; }
__device__ __forceinline__ unsigned cvtpk(float lo, float hi) { unsigned r; asm volatile("v_cvt_pk_bf16_f32 %0, %1, %2" : "=v"(r) : "v"(lo), "v"(hi)); return r; }

__device__ __forceinline__ void mask_tile(f32x16& p0, f32x16& p1, int dq, unsigned W) {
    const float NEG = -__builtin_inff();
#pragma unroll
    for (int r = 0; r < 16; ++r) {
        const int c = (r & 3) + 8 * (r >> 2);
        if ((unsigned)(dq - c) >= W) p0[r] = NEG;
        if ((unsigned)(dq - c - 32) >= W) p1[r] = NEG;
    }
}
__device__ __forceinline__ void partialSM(f32x16& p0, f32x16& p1, float& m_reg, float& mn, float& alpha) {
    float pmax = p0[0];
#pragma unroll
    for (int r = 1; r < 16; ++r) pmax = fmaxf(pmax, p0[r]);
#pragma unroll
    for (int r = 0; r < 16; ++r) pmax = fmaxf(pmax, p1[r]);
    { auto rr = __builtin_amdgcn_permlane32_swap(__float_as_uint(pmax), __float_as_uint(pmax), false, false);
      pmax = fmaxf(__uint_as_float(rr[0]), __uint_as_float(rr[1])); }
    if (__builtin_expect(__all((pmax - m_reg) * SCALE <= THR), 1)) { mn = m_reg; alpha = 1.f; }
    else { mn = fmaxf(m_reg, pmax); alpha = __builtin_amdgcn_exp2f((m_reg - mn) * C2); m_reg = mn; }
    const float mnL = -mn * C2;
#pragma unroll
    for (int r = 0; r < 16; ++r) p0[r] = fmaf(p0[r], C2, mnL);
#pragma unroll
    for (int r = 0; r < 16; ++r) p1[r] = fmaf(p1[r], C2, mnL);
#pragma unroll
    for (int r = 0; r < 16; ++r) p0[r] = __builtin_amdgcn_exp2f(p0[r]);
}
__device__ __forceinline__ void finishSM(f32x16& p0, f32x16& p1, float alpha, float& l_reg, bf16x8& pa0, bf16x8& pa1, bf16x8& pa2, bf16x8& pa3) {
#pragma unroll
    for (int r = 0; r < 16; ++r) p1[r] = __builtin_amdgcn_exp2f(p1[r]);
    float ps = 0;
#pragma unroll
    for (int r = 0; r < 16; ++r) ps += p0[r];
#pragma unroll
    for (int r = 0; r < 16; ++r) ps += p1[r];
    { auto rr = __builtin_amdgcn_permlane32_swap(__float_as_uint(ps), __float_as_uint(ps), false, false);
      ps = __uint_as_float(rr[0]) + __uint_as_float(rr[1]); }
    l_reg = l_reg * alpha + ps;
#define PK4(P, B_, OUT) do { unsigned a0 = cvtpk(P[B_+0], P[B_+1]), a1 = cvtpk(P[B_+2], P[B_+3]);                          \
        unsigned b0 = cvtpk(P[B_+4], P[B_+5]), b1 = cvtpk(P[B_+6], P[B_+7]);                                             \
        auto r0 = __builtin_amdgcn_permlane32_swap(a0, b0, false, false); auto r1 = __builtin_amdgcn_permlane32_swap(a1, b1, false, false); \
        u32x4 w = {r0[0], r1[0], r0[1], r1[1]}; OUT = *reinterpret_cast<bf16x8*>(&w); } while (0)
    PK4(p0, 0, pa0); PK4(p0, 8, pa1); PK4(p1, 0, pa2); PK4(p1, 8, pa3);
#undef PK4
}
template <int KB>
__device__ __forceinline__ void qkt(f32x16& p0, f32x16& p1, const char* K_lds, int r32, int hi, const bf16x8* qr, const float init = 0.f) {
#pragma unroll
    for (int r = 0; r < 16; ++r) { p0[r] = init; p1[r] = init; }
    const char* kb[4];
#pragma unroll
    for (int dd = 0; dd < 4; ++dd) kb[dd] = K_lds + kb_off(KB) + KSWZ(r32, (dd * 16 + hi * 8) * 2);
#pragma unroll
    for (int d0 = 0; d0 < 8; ++d0) { const char* a = kb[d0 & 3] + (d0 >> 2) * 128;
        bf16x8 b0 = *reinterpret_cast<const bf16x8*>(a);
        bf16x8 b1 = *reinterpret_cast<const bf16x8*>(a + 32 * 256);
        p0 = __builtin_amdgcn_mfma_f32_32x32x16_bf16(b0, qr[d0], p0, 0, 0, 0);
        p1 = __builtin_amdgcn_mfma_f32_32x32x16_bf16(b1, qr[d0], p1, 0, 0, 0);
        if (d0 == 3) SBAR(); }
}
template <int VB>
__device__ __forceinline__ void pv_tile(f32x16* o, int vb0_, int vb2_, bf16x8 pa0, bf16x8 pa1, bf16x8 pa2, bf16x8 pa3) {
    const int vb0 = VB == 2 ? vb2_ : vb0_;
#define TRRD(dst, off) asm volatile("ds_read_b64_tr_b16 %0, %1 offset:%2" : "=&v"(dst) : "v"(vb0), "i"(off) : "memory")
#define PV_D0(d0) do { s16x4 l0, l1, l2, l3, h0, h1, h2, h3; constexpr int b_ = (VB < 2 ? VB * SHM_V : 0) + v_rd_off(d0, 0, 0); \
        TRRD(l0, b_); TRRD(h0, b_ + 2048); TRRD(l1, b_ + 4096); TRRD(h1, b_ + 6144); TRRD(l2, b_ + 8192); TRRD(h2, b_ + 10240); TRRD(l3, b_ + 12288); TRRD(h3, b_ + 14336); \
        asm volatile("s_waitcnt lgkmcnt(0)" ::: "memory"); SBAR(); \
        o[d0] = __builtin_amdgcn_mfma_f32_32x32x16_bf16(pa0, (bf16x8){l0[0], l0[1], l0[2], l0[3], h0[0], h0[1], h0[2], h0[3]}, o[d0], 0, 0, 0);   \
        o[d0] = __builtin_amdgcn_mfma_f32_32x32x16_bf16(pa1, (bf16x8){l1[0], l1[1], l1[2], l1[3], h1[0], h1[1], h1[2], h1[3]}, o[d0], 0, 0, 0);   \
        o[d0] = __builtin_amdgcn_mfma_f32_32x32x16_bf16(pa2, (bf16x8){l2[0], l2[1], l2[2], l2[3], h2[0], h2[1], h2[2], h2[3]}, o[d0], 0, 0, 0);   \
        o[d0] = __builtin_amdgcn_mfma_f32_32x32x16_bf16(pa3, (bf16x8){l3[0], l3[1], l3[2], l3[3], h3[0], h3[1], h3[2], h3[3]}, o[d0], 0, 0, 0); } while (0)
    PV_D0(0); PV_D0(1); PV_D0(2); PV_D0(3);
#undef PV_D0
#undef TRRD
}

struct KVSrc { const bf16_t* k; const bf16_t* v; int ld; int tstride; int toff; };
struct DmaOff { unsigned k[2], v[2]; };
__device__ __forceinline__ void dma_offsets(DmaOff& d, const KVSrc& s, int wid, int lane) {
    const unsigned rs = (unsigned)(s.tstride * s.ld * 2);
#pragma unroll
    for (int i = 0; i < 2; ++i) {
        const int ci = 2 * wid + i, row = 4 * ci + (lane >> 4), colB = ((lane & 15) * 16) ^ ((row & 7) << 4);
        d.k[i] = (unsigned)row * rs + (unsigned)colB;
        const int kk = (ci >> 1) * 8 + ((lane & 31) >> 2), k = (kk & ~0xC) | ((kk & 4) << 1) | ((kk & 8) >> 1), c = (2 * (ci & 1) + (lane >> 5)) * 32 + (lane & 3) * 8;
        d.v[i] = (unsigned)k * rs + (unsigned)c * 2u;
    }
}
template <int BF> __device__ __forceinline__ void dma_issue(const DmaOff& d, const KVSrc& s, int kb, LAS unsigned char* ldsl, int wid) {
    const size_t tb = (size_t)(kb * s.tstride + s.toff) * s.ld * 2;
    const char* kt = (const char*)s.k + tb; const char* vt = (const char*)s.v + tb;
#pragma unroll
    for (int i = 0; i < 2; ++i) {
        __builtin_amdgcn_global_load_lds((const unsigned*)(kt + d.k[i]), (LAS unsigned*)(ldsl + kb_off(BF) + (2 * wid + i) * 1024), 16, 0, 0);
        __builtin_amdgcn_global_load_lds((const unsigned*)(vt + d.v[i]), (LAS unsigned*)(ldsl + vb_off(BF) + (2 * wid + i) * 1024), 16, 0, 0);
    }
}

enum { MODE_BAND = 0, MODE_SEL = 1, MODE_STATS = 2, MODE_IMP = 3 };
template <int MODE>
__device__ __forceinline__ void branch_prefetch(char* lds, const KVSrc& src, int j_lo, int j_hi, unsigned long long tmask, const int wid) {
    const int lane = tid_of(wid) & 63;
    LAS unsigned char* ldsl = (LAS unsigned char*)(unsigned)(uintptr_t)lds;
    DmaOff dof; dma_offsets(dof, src, wid, lane);
    auto next_tile = [&](int j) -> int { if (MODE == MODE_SEL) { while (j < j_hi && !((tmask >> j) & 1ull)) ++j; } return j; };
    const int j = next_tile(j_lo);
    if (j >= j_hi) return;
    dma_issue<0>(dof, src, j * 64, ldsl, wid);
    if constexpr (MODE == MODE_BAND || MODE == MODE_SEL) { const int jnx = next_tile(j + 1); if (jnx < j_hi) dma_issue<1>(dof, src, jnx * 64, ldsl, wid); }
}
template <int MODE, bool PREF = false>
__device__ __forceinline__ void run_branch(char* lds, const bf16x8* qr, const KVSrc& src, int j_lo, int j_hi, unsigned long long tmask,
                                           int qidx, int qlo_wave, unsigned W, unsigned long long own, f32x16* o, float& m_reg, float& l_reg,
                                           int imp_row  , const int wid) {
    const int tid = tid_of(wid), lane = tid & 63, r32 = lane & 31, hi = lane >> 5;
    LAS unsigned char* ldsl = (LAS unsigned char*)(unsigned)(uintptr_t)lds;
    const int vb0 = (int)(uintptr_t)(lds + L_V) + v_rd_base(lane), vb2 = (int)(uintptr_t)(lds + vb_off(2)) + v_rd_base(lane);
    float* wsf = (float*)(lds + L_WS) + wid * 64;
    const char* K_lds = lds;
    DmaOff dof; dma_offsets(dof, src, wid, lane);
    auto next_tile = [&](int j) -> int { if (MODE == MODE_SEL) { while (j < j_hi && !((tmask >> j) & 1ull)) ++j; } return j; };
    int j = next_tile(j_lo);
    if (j >= j_hi) { __syncthreads(); return; }
    constexpr bool RING = (MODE == MODE_BAND || MODE == MODE_SEL);
    int jnx = j_hi;
    if constexpr (PREF) { if constexpr (RING) jnx = next_tile(j + 1); asm volatile("s_waitcnt vmcnt(0)" ::: "memory"); }
    else {
        dma_issue<0>(dof, src, j * 64, ldsl, wid);
        if constexpr (RING) { jnx = next_tile(j + 1); if (jnx < j_hi) { dma_issue<1>(dof, src, jnx * 64, ldsl, wid); asm volatile("s_waitcnt vmcnt(4)" ::: "memory"); } else asm volatile("s_waitcnt vmcnt(0)" ::: "memory"); }
        else asm volatile("s_waitcnt vmcnt(0)" ::: "memory");
    }
    __syncthreads();
    float carry = 0.f;
    const float rl = (MODE == MODE_IMP) ? (l_reg > 0.f ? 1.f / l_reg : 0.f) : 0.f;
#define FA_STEP(KB) { \
        int jn; bool more; bool issued_ = false; \
        if constexpr (RING) { jn = jnx; more = jn < j_hi; const int j2_ = more ? next_tile(jn + 1) : j_hi; issued_ = j2_ < j_hi; if (issued_) dma_issue<(KB + 2) % 3>(dof, src, j2_ * 64, ldsl, wid); jnx = j2_; } \
        else { jn = next_tile(j + 1); more = jn < j_hi; if (more) dma_issue<1 - (KB & 1)>(dof, src, jn * 64, ldsl, wid); } \
        SBAR(); \
        f32x16 p0, p1; \
        const int kb_ = j * 64; \
        const bool act = (MODE != MODE_BAND) || (kb_ <= qlo_wave + 31 && kb_ + 63 + (int)W > qlo_wave); \
        if (act) { \
            qkt<KB>(p0, p1, K_lds, r32, hi, qr, (MODE == MODE_SEL && !((own >> j) & 1ull)) ? -__builtin_inff() : 0.f);     \
            if (MODE == MODE_SEL) { if (kb_ + 63 > qlo_wave) mask_tile(p0, p1, qidx - kb_ - 4 * hi, 0x7fffffffu); } \
            else { if (kb_ + 63 > qlo_wave || kb_ + (int)W <= qlo_wave + 31) mask_tile(p0, p1, qidx - kb_ - 4 * hi, W); } \
            if (MODE == MODE_IMP) { \
                const float mnL = -m_reg * C2; \
                _Pragma("unroll") for (int r = 0; r < 16; ++r) { p0[r] = __builtin_amdgcn_exp2f(fmaf(p0[r], C2, mnL)) * rl; p1[r] = __builtin_amdgcn_exp2f(fmaf(p1[r], C2, mnL)) * rl; } \
                float G0[4], G1[4], PL0[4], PL1[4]; \
                _Pragma("unroll") for (int g4 = 0; g4 < 4; ++g4) { G0[g4] = (p0[4 * g4] + p0[4 * g4 + 1]) + (p0[4 * g4 + 2] + p0[4 * g4 + 3]); G1[g4] = (p1[4 * g4] + p1[4 * g4 + 1]) + (p1[4 * g4 + 2] + p1[4 * g4 + 3]); \
                    PL0[g4] = __shfl_xor(p0[4 * g4 + 3], 32); PL1[g4] = __shfl_xor(p1[4 * g4 + 3], 32); } \
                float* ip = (float*)(lds + L_IMP) + imp_row * 64 + (j - j_lo) * 16; \
                _Pragma("unroll") for (int g4 = 0; g4 < 4; ++g4) { \
                    const float prev0 = hi ? PL0[g4] : (g4 ? PL0[g4 - 1] : carry); \
                    const float prev1 = hi ? PL1[g4] : (g4 ? PL1[g4 - 1] : PL0[3]); \
                    ip[2 * g4 + hi] = G0[g4] + prev0; ip[8 + 2 * g4 + hi] = G1[g4] + prev1; } \
                carry = PL1[3]; \
            } else { \
                float mn, alpha; partialSM(p0, p1, m_reg, mn, alpha); \
                if (MODE != MODE_STATS) { if (__any(alpha < 1.f)) { if (hi == 0) wsf[r32] = alpha; asm volatile("s_waitcnt lgkmcnt(0)" ::: "memory"); \
                    _Pragma("unroll") for (int d_ = 0; d_ < 4; ++d_) _Pragma("unroll") for (int r = 0; r < 16; ++r) o[d_][r] *= wsf[crow(r, hi)]; } } \
                bf16x8 pa0, pa1, pa2, pa3; finishSM(p0, p1, alpha, l_reg, pa0, pa1, pa2, pa3); SBAR(); \
                if (MODE != MODE_STATS) pv_tile<KB>(o, vb0, vb2, pa0, pa1, pa2, pa3); \
            } \
        } \
        if (RING && issued_) asm volatile("s_waitcnt vmcnt(4)" ::: "memory"); else asm volatile("s_waitcnt vmcnt(0)" ::: "memory");     \
        __syncthreads(); \
        if (!more) break; \
        j = jn; }
    if constexpr (RING) { for (;;) { FA_STEP(0) FA_STEP(1) FA_STEP(2) } } else { for (;;) { FA_STEP(0) FA_STEP(1) } }
#undef FA_STEP
}
}
namespace fa {
constexpr unsigned W_INF = 1u << 20;
__device__ __forceinline__ int opq_s(int x) { asm volatile("" : "+s"(x)); return x; }
__device__ __forceinline__ int opq_v(int x) { asm volatile("" : "+v"(x)); return x; }
template <int EMODE>
__device__ __forceinline__ void branch_epilogue(const f32x16* o, float sc_row, float* wsf, float* scratch, bf16_t* outw  , int ldo, int r32, int hi, int tid) {
    if (hi == 0) wsf[r32] = sc_row;
    asm volatile("s_waitcnt lgkmcnt(0)" ::: "memory");
    float rs[16];
#pragma unroll
    for (int r = 0; r < 16; ++r) rs[r] = wsf[crow(r, hi)];
    const unsigned voff = (unsigned)tid * 16u;
#pragma unroll
    for (int rg = 0; rg < 4; ++rg) {
        f32x4 sv[4];
        if (EMODE == 1 || EMODE == 2) {
#pragma unroll
            for (int d0 = 0; d0 < 4; ++d0) sv[d0] = *(const f32x4*)((const char*)scratch + (rg * 4 + d0) * 8192 + voff);
        }
#pragma unroll
        for (int d0 = 0; d0 < 4; ++d0) {
            f32x4 v;
#pragma unroll
            for (int r4 = 0; r4 < 4; ++r4) v[r4] = o[d0][rg * 4 + r4] * rs[rg * 4 + r4];
            if (EMODE == 1 || EMODE == 2) v += sv[d0];
            if (EMODE == 0 || EMODE == 1) *(f32x4*)((char*)scratch + (rg * 4 + d0) * 8192 + voff) = v;
            else {
#pragma unroll
                for (int r4 = 0; r4 < 4; ++r4) { const float vn = __shfl_xor(v[r4], 1);
                    if ((r32 & 1) == 0) *(unsigned*)(outw + (size_t)crow(rg * 4 + r4, hi) * ldo + d0 * 32 + r32) = cvtpk(v[r4], vn); }
            }
        }
        asm volatile("" ::: "memory");
    }
    asm volatile("s_waitcnt lgkmcnt(0)" ::: "memory");
}

__device__ __forceinline__ void nsa_unit(char* lds, unsigned char* ws, int L, const int wid, const int probe = 0) {
    const int cur = 63 - (L & 63), bg = L >> 6, b = bg >> 1, g = bg & 1, t0 = cur * 64;
    const int tid = tid_of(wid), lane = tid & 63, r32 = lane & 31, hi = lane >> 5;
    const int r = wid >> 1, qh = (wid & 1) * 32, qi = qh + r32, t = t0 + qi;
    const unsigned char* pj = ws + WS_PROJ;
    bf16x8 qr[8];
#pragma unroll
    for (int d0 = 0; d0 < 8; ++d0) qr[d0] = *(const bf16x8*)((const bf16_t*)(pj + PJ_QN) + ((size_t)(b * 8 + g * 4 + r) * S_ + t) * 128 + d0 * 16 + hi * 8);
    float* wsf = (float*)(lds + L_WS) + wid * 64;
#define NSA_GATE(br) bf2f(((const bf16_t*)(ws + WS_PROJ + PJ_GL))[(size_t)(opq_s(b) * S_ + opq_v(t)) * 32 + g * 12 + r * 3 + (br)])
#define NSA_SCRATCH() ((float*)(ws + WS_SCR) + (size_t)opq_s((int)blockIdx.x) * (64 * 512))
#define NSA_OUTW() ((bf16_t*)(ws + (probe ? WS_MERGED : WS_ONSAB)) + (size_t)(opq_s(b) * S_ + t0 + qh) * 1024 + (g * 4 + r) * 128)
    f32x16 o[4]; float m_reg, l_reg;
#define FA_RESET() do { _Pragma("unroll") for (int d_ = 0; d_ < 4; ++d_) o[d_] = f32x16{}; m_reg = -1e30f; l_reg = 0.f; } while (0)
    {
        const bf16_t* kc = (const bf16_t*)(ws + WS_KCB) + (size_t)(b * 2 + g) * 256 * 128; const bf16_t* vc = (const bf16_t*)(ws + WS_VCB) + (size_t)(b * 2 + g) * 256 * 128;
        const KVSrc src{kc, vc, 128, 1, 0};
        const int qc = (t - 31) >> 4, qc_lo = (t0 + qh - 31) >> 4, ntc = (4 * cur + 3 + 63) >> 6;
        FA_RESET();
        run_branch<MODE_BAND>(lds, qr, src, 0, ntc, 0ull, qc, qc_lo, W_INF, 0ull, o, m_reg, l_reg, 0, wid);
        branch_prefetch<MODE_IMP>(lds, src, 0, ntc, 0ull, wid);
        { const float g0 = NSA_GATE(0); branch_epilogue<0>(o, l_reg > 0.f ? g0 / l_reg : 0.f, wsf, NSA_SCRATCH(), nullptr, 1024, r32, hi, tid); }
        run_branch<MODE_IMP, true>(lds, qr, src, 0, ntc, 0ull, qc, qc_lo, W_INF, 0ull, o, m_reg, l_reg, r * 64 + qi, wid);
    }
    const size_t hoff = (size_t)(b * 2 + g) * S_ * 128;
    const KVSrc wsrc{(const bf16_t*)(pj + PJ_KV + 4 * 16 * MiB) + hoff, (const bf16_t*)(pj + PJ_KV + 5 * 16 * MiB) + hoff, 128, 1, 0};
    const KVSrc ssrc{(const bf16_t*)(pj + PJ_KV + 2 * 16 * MiB) + hoff, (const bf16_t*)(pj + PJ_KV + 3 * 16 * MiB) + hoff, 128, 1, 0};
    const int wj_lo = cur >= 8 ? cur - 8 : 0;
    if (!(probe & 2)) branch_prefetch<MODE_BAND>(lds, wsrc, wj_lo, cur + 1, 0ull, wid);
    {
        const float* imp = (const float*)(lds + L_IMP); unsigned long long* selm = (unsigned long long*)(lds + L_SELM);
#pragma unroll 1
        for (int q8 = 0; q8 < 8; ++q8) {
            const int q = wid * 8 + q8, j = lane;
            float v = -1e30f;
            if (j <= cur) v = ((imp[(0 * 64 + q) * 64 + j] + imp[(1 * 64 + q) * 64 + j]) + imp[(2 * 64 + q) * 64 + j]) + imp[(3 * 64 + q) * 64 + j];
            if (j == 0 || j == cur || j == cur - 1) v = 1e9f;
            unsigned sb = __float_as_uint(v); sb = (sb & 0x80000000u) ? ~sb : (sb | 0x80000000u);
            const unsigned klo = (sb << 6) | (unsigned)(63 - j), khi = sb >> 26;
            const unsigned long long key = ((unsigned long long)khi << 32) | klo;
            int rank = 0;
#pragma unroll
            for (int i = 0; i < 64; ++i) {
                const unsigned long long ku = ((unsigned long long)(unsigned)__builtin_amdgcn_readlane((int)khi, i) << 32) | (unsigned)__builtin_amdgcn_readlane((int)klo, i);
                rank += (ku > key) ? 1 : 0; }
            const unsigned long long m = __ballot(rank < 16);
            if (lane == 0) selm[q] = m;
        }
        __syncthreads();
    }
    unsigned long long own, uni;
    {
        const unsigned long long* selm = (const unsigned long long*)(lds + L_SELM);
        own = selm[qi];
        unsigned long long x = selm[lane]; unsigned xl = (unsigned)x, xh = (unsigned)(x >> 32);
#pragma unroll
        for (int o_ = 1; o_ < 64; o_ <<= 1) { xl |= (unsigned)__shfl_xor((int)xl, o_); xh |= (unsigned)__shfl_xor((int)xh, o_); }
        uni = ((unsigned long long)(unsigned)__builtin_amdgcn_readfirstlane((int)xh) << 32) | (unsigned)__builtin_amdgcn_readfirstlane((int)xl);
    }
    if (!(probe & 2)) {
        FA_RESET();
        run_branch<MODE_BAND, true>(lds, qr, wsrc, wj_lo, cur + 1, 0ull, t, t0 + qh, 512u, 0ull, o, m_reg, l_reg, 0, wid);
        if (!(probe & 1)) branch_prefetch<MODE_SEL>(lds, ssrc, 0, cur + 1, uni, wid);
        { const float g2 = NSA_GATE(2); branch_epilogue<1>(o, g2 / l_reg, wsf, NSA_SCRATCH(), nullptr, 1024, r32, hi, tid); }
    }
    if (!(probe & 1)) {
        FA_RESET();
        if (probe & 2) branch_prefetch<MODE_SEL>(lds, ssrc, 0, cur + 1, uni, wid);
        run_branch<MODE_SEL, true>(lds, qr, ssrc, 0, cur + 1, uni, t, t0 + qh, 0u, own, o, m_reg, l_reg, 0, wid);
        { const float g1 = NSA_GATE(1); branch_epilogue<2>(o, g1 / l_reg, wsf, NSA_SCRATCH(), NSA_OUTW(), 1024, r32, hi, tid); }
    }
#undef FA_RESET
#undef NSA_GATE
#undef NSA_SCRATCH
#undef NSA_OUTW
}

__device__ __forceinline__ void dil_unit(char* lds, unsigned char* ws, int L, const int wid) {
    const int cfg = L >> 9, rem = L & 511, bh = rem >> 4, pt = rem & 15, b = bh >> 2, h = bh & 3;
    const int dl = cfg * 2, d = 1 << dl, ntile = 16 >> dl;
    const int u = pt / ntile, p0 = (pt % ntile) * 256;
    const int tid = tid_of(wid), lane = tid & 63, r32 = lane & 31, hi = lane >> 5;
    const int p = p0 + wid * 32 + r32, tok = b * S_ + p * d + u;
    const unsigned char* pj = ws + WS_PROJ;
    const size_t hrow0 = (size_t)(b * 4 + h) * S_;
    const int ls = S_ >> dl;
    bf16x8 qr[8];
#pragma unroll
    for (int d0 = 0; d0 < 8; ++d0) qr[d0] = *(const bf16x8*)((const bf16_t*)(pj + PJ_DIL + (size_t)(cfg * 3 + 0) * 32 * MiB) + (hrow0 + (size_t)u * ls + p) * 128 + d0 * 16 + hi * 8);
    const KVSrc src{(const bf16_t*)(pj + PJ_DIL + (size_t)(cfg * 3 + 1) * 32 * MiB) + (hrow0 + (size_t)u * ls) * 128, (const bf16_t*)(pj + PJ_DIL + (size_t)(cfg * 3 + 2) * 32 * MiB) + (hrow0 + (size_t)u * ls) * 128, 128, 1, 0};
    f32x16 o[4];
#pragma unroll
    for (int d_ = 0; d_ < 4; ++d_) o[d_] = f32x16{};
    float m_reg = -1e30f, l_reg = 0.f;
    run_branch<MODE_BAND>(lds, qr, src, p0 >= 128 ? (p0 - 128) >> 6 : 0, (p0 >> 6) + 4, 0ull, p, p0 + wid * 32, 129u, 0ull, o, m_reg, l_reg, 0, wid);
    float* wsf = (float*)(lds + L_WS) + wid * 64;
    bf16_t* outw = (bf16_t*)(ws + WS_ODP) + (size_t)cfg * T_ * 512 + (size_t)(b * S_ + (p0 + wid * 32) * d + u) * 512 + h * 128;
    branch_epilogue<3>(o, 1.f / l_reg, wsf, nullptr, outw, 512 * d, r32, hi, tid);
    if (hi == 0) ((float*)(ws + WS_LSE))[(size_t)cfg * T_ * 4 + (size_t)tok * 4 + h] = m_reg * SCALE + logf(l_reg);
}

__device__ __forceinline__ void dil_combine(unsigned char* ws, int gt, int NGT) {
    const bf16_t* od = (const bf16_t*)(ws + WS_ODP); const float* lse = (const float*)(ws + WS_LSE); bf16_t* o = (bf16_t*)(ws + WS_ODILB);
    for (size_t i = (size_t)gt; i < (size_t)T_ * 64; i += NGT) {
        const size_t tok = i >> 6; const int c8 = (int)(i & 63) * 8, h = c8 >> 7;
        const float l0 = lse[tok * 4 + h], l1 = lse[(size_t)T_ * 4 + tok * 4 + h], l2 = lse[(size_t)2 * T_ * 4 + tok * 4 + h];
        const float m = fmaxf(l0, fmaxf(l1, l2)); float e0 = expf(l0 - m), e1 = expf(l1 - m), e2 = expf(l2 - m); const float inv = 1.f / (e0 + e1 + e2); e0 *= inv; e1 *= inv; e2 *= inv;
        const u32x4 a0 = *(const u32x4*)(od + tok * 512 + c8), a1 = *(const u32x4*)(od + (size_t)T_ * 512 + tok * 512 + c8), a2 = *(const u32x4*)(od + (size_t)2 * T_ * 512 + tok * 512 + c8);
        u32x4 w;
#pragma unroll
        for (int k = 0; k < 4; ++k) {
            const float lo = e0 * __uint_as_float(a0[k] << 16) + e1 * __uint_as_float(a1[k] << 16) + e2 * __uint_as_float(a2[k] << 16);
            const float hi_ = e0 * __uint_as_float(a0[k] & 0xffff0000u) + e1 * __uint_as_float(a1[k] & 0xffff0000u) + e2 * __uint_as_float(a2[k] & 0xffff0000u);
            w[k] = cvtpk(lo, hi_);
        }
        *(u32x4*)(o + tok * 512 + c8) = w;
    }
}

constexpr int CP_LD = 144;
constexpr int CP_A = 0, CP_B = 2 * 32 * CP_LD, CP_HID = CP_B + 2 * 256 * CP_LD, CP_HLD = 528;
static_assert(CP_HID + 32 * CP_HLD <= LDSCTL_OFF, "compress LDS map");
__device__ __forceinline__ void compress_unit(char* lds, unsigned char* ws, int unit, const int wid) {
    const int which = unit >> 7, R0 = (unit & 127) * 32;
    const int tid = tid_of(wid), lane = tid & 63, n32 = lane & 31, hi = lane >> 5;
    const bf16_t* w1t = (const bf16_t*)(ws + WS_CW1) + (size_t)which * 256 * 4096;
    const bf16_t* w2t = (const bf16_t*)(ws + WS_CW2) + (size_t)which * 128 * 256;
    const float* posb = (const float*)(ws + WS_POSB) + which * 16 * 256;
    const int ar = (tid >> 3) & 31, ap = tid & 7;
    const int Rr = R0 + ar, bgc = Rr >> 8, c = (Rr & 255) < 254 ? (Rr & 255) : 254, bb = bgc >> 1, gg = bgc & 1;
    const bf16_t* asrc = (const bf16_t*)(ws + WS_PROJ + PJ_KV + (size_t)(which ? 1 : 0) * 16 * MiB) + ((size_t)(bb * 2 + gg) * S_ + 16 * c) * 128 + ap * 8;
    bf16x8 sa0, sa1, sa2, sa3, sb0[4], sb1[4], sb2[4], sb3[4];
#define CP_LOAD(S, kt) do { if (tid < 256) sa##S = *(const bf16x8*)(asrc + (size_t)((kt) >> 1) * 128 + ((kt) & 1) * 64); \
        _Pragma("unroll") for (int i = 0; i < 4; ++i) { const int idx = tid + 512 * i; sb##S[i] = *(const bf16x8*)(w1t + (size_t)(idx >> 3) * 4096 + (kt) * 64 + (idx & 7) * 8); } } while (0)
#define CP_WRITE(S, bf) do { if (tid < 256) *(bf16x8*)(lds + CP_A + (bf) * 32 * CP_LD + ar * CP_LD + ap * 16) = sa##S; \
        _Pragma("unroll") for (int i = 0; i < 4; ++i) { const int idx = tid + 512 * i; *(bf16x8*)(lds + CP_B + (bf) * 256 * CP_LD + (idx >> 3) * CP_LD + (idx & 7) * 16) = sb##S[i]; } } while (0)
#define CP_STEP(k, LS, WS) do { const int k_ = (k); \
        if (k_ + 3 < 64) CP_LOAD(LS, k_ + 3); \
        { const char* ab = lds + CP_A + (k_ & 1) * 32 * CP_LD + n32 * CP_LD + hi * 16; \
          const char* bbp = lds + CP_B + (k_ & 1) * 256 * CP_LD + (wid * 32 + n32) * CP_LD + hi * 16; \
          _Pragma("unroll") for (int ks = 0; ks < 4; ++ks) { const bf16x8 af = *(const bf16x8*)(ab + ks * 32), bfv = *(const bf16x8*)(bbp + ks * 32); acc = __builtin_amdgcn_mfma_f32_32x32x16_bf16(af, bfv, acc, 0, 0, 0); } } \
        if (k_ + 1 < 64) { if (k_ + 3 < 64) asm volatile("s_waitcnt vmcnt(8)" ::: "memory"); else if (k_ + 2 < 64) asm volatile("s_waitcnt vmcnt(4)" ::: "memory"); else asm volatile("s_waitcnt vmcnt(0)" ::: "memory"); \
            CP_WRITE(WS, (k_ + 1) & 1); } \
        __syncthreads(); } while (0)
    f32x16 acc = f32x16{};
    CP_LOAD(0, 0); CP_LOAD(1, 1); CP_LOAD(2, 2);
    asm volatile("s_waitcnt vmcnt(8)" ::: "memory"); CP_WRITE(0, 0); __syncthreads();
#pragma unroll 1
    for (int kt = 0; kt < 64; kt += 4) {
        CP_STEP(kt, 3, 1); CP_STEP(kt + 1, 0, 2); CP_STEP(kt + 2, 1, 3); CP_STEP(kt + 3, 2, 0);
    }
#undef CP_LOAD
#undef CP_WRITE
#undef CP_STEP
    { float pb = 0.f;
#pragma unroll
      for (int c = 0; c < 16; ++c) pb += posb[c * 256 + wid * 32 + n32];
#pragma unroll
      for (int r = 0; r < 16; ++r) { const float hv = gelu_tanh(acc[r] + pb); const unsigned pk = cvtpk(hv, 0.f); *(bf16_t*)(lds + CP_HID + crow(r, hi) * CP_HLD + (wid * 32 + n32) * 2) = (bf16_t)pk; } }
    __syncthreads();
    if (wid < 4) {
        f32x16 a2 = f32x16{};
#pragma unroll
        for (int ks = 0; ks < 16; ++ks) {
            const bf16x8 af = *(const bf16x8*)(lds + CP_HID + n32 * CP_HLD + ks * 32 + hi * 16);
            const bf16x8 bfv = *(const bf16x8*)(w2t + (size_t)(wid * 32 + n32) * 256 + ks * 16 + hi * 8);
            a2 = __builtin_amdgcn_mfma_f32_32x32x16_bf16(af, bfv, a2, 0, 0, 0);
        }
        bf16_t* outp = (bf16_t*)(ws + (which ? WS_VCB : WS_KCB));
#pragma unroll
        for (int r = 0; r < 16; ++r) { const float v = a2[r], vn = __shfl_xor(v, 1);
            if ((n32 & 1) == 0) *(unsigned*)(outp + (size_t)(R0 + crow(r, hi)) * 128 + wid * 32 + n32) = cvtpk(v, vn); }
    }
    __syncthreads();
}
}
#ifndef F8_FUDGE
#define F8_FUDGE 1.f
#endif
#ifndef PROBE_NSA_FLAGS
#define PROBE_NSA_FLAGS 0
#endif
#ifndef PROBE_ATT_PART
#define PROBE_ATT_PART 0
#endif
#ifndef PROBE_DUP
#define PROBE_DUP (-1)
#endif
#define REPS(ph) for (int rep_ = 0; rep_ < ((PROBE_DUP) == (ph) ? 2 : 1); ++rep_)
enum { PH_PROLOGUE = 0, PH_INPROJ, PH_COMPRESS, PH_ATTN, PH_BRA, PH_BRB, PH_WOUT, PH_LN1, PH_SCATTER, PH_UP, PH_DOWN, PH_FINAL, PH_COUNT };
__global__ void __launch_bounds__(NWAVES * 64, 2) mk_fwd(Args args) {
    extern __shared__ __attribute__((aligned(16))) unsigned char lds_raw[];
    Frame F;
    F.lds = (LAS unsigned char*)lds_raw;
    F.MISC = (volatile LAS unsigned*)(F.lds + MISC_OFF);
    F.tid = threadIdx.x; F.lane = F.tid & 63; F.wave = __builtin_amdgcn_readfirstlane(F.tid >> 6);
    F.G = gridDim.x; { const int bx = blockIdx.x; F.vcu = (F.G % 8 == 0) ? (bx % 8) * (F.G / 8) + bx / 8 : bx; }
    unsigned char* ws = args.ws;
    F.ctl = (unsigned*)(ws + WS_CTL);
    for (int u = F.tid; u < (LDS_BYTES - LDSCTL_OFF) / 4; u += NWAVES * 64) ((LAS unsigned*)(F.lds + LDSCTL_OFF))[u] = 0u;
    __syncthreads();
    XcdBarrier bar = xcd_barrier_post(F.ctl + CW_BAR + args.li * XCD_BAR_WORDS, F.MISC + 8);
    const int lo = args.ph_lo, hi = args.ph_hi;
#define IN(k) (lo <= (k) && (k) < hi)
#define REFRAME() do { const int t_ = tid_of(F.wave); F.tid = t_; F.lane = t_ & 63; } while (0)
#define BOTH(k) (IN(k) && IN((k) + 1))
    if (IN(PH_PROLOGUE)) { REFRAME(); REPS(PH_PROLOGUE) p0_prologue(F, args); if (BOTH(PH_PROLOGUE)) xcd_barrier(bar, tid_of(F.wave) == 0); }
    if (IN(PH_INPROJ)) {
        pg8::Gemm g{(const bf16_t*)(ws + WS_XB), (const bf16_t*)(ws + WS_WIN), DM, nullptr};
        pg8::StaticOrder S; S.init(T_ / 256, 44, F.G, (int)blockIdx.x);
        pg8::EpiInProj E{ws + WS_PROJ, (const float*)(ws + WS_BINP), (const float*)(ws + WS_ROPE), (const float*)(ws + WS_ROPE) + 4096 * 64};
        REPS(PH_INPROJ) pg8::gemm_phase<pg8::EpiInProj, pg8::StaticOrder, false>(F.lds + RING_OFF, g, S, E, F.wave);
#ifdef PROBE_NULL_INPROJ
        { pg8::EpiNull EN; pg8::gemm_phase<pg8::EpiNull, pg8::StaticOrder, false>(F.lds + RING_OFF, g, S, EN, F.wave); }
#endif
        if (BOTH(PH_INPROJ)) xcd_barrier(bar, tid_of(F.wave) == 0);
    }
    if (IN(PH_COMPRESS)) { REFRAME();
        REPS(PH_COMPRESS) for (int u = (int)blockIdx.x; u < 256; u += F.G) fa::compress_unit((char*)lds_raw, ws, u, F.wave);
        if (BOTH(PH_COMPRESS)) xcd_barrier(bar, tid_of(F.wave) == 0);
    }
    if (IN(PH_ATTN)) { REFRAME();
        volatile LAS int* qslot = (volatile LAS int*)(F.lds + fa::L_MISC);
        LAS float* tscr = (LAS float*)(F.lds + F.wave * SCR_WAVE_BYTES);
#define MOE_W_POP() ({ if (F.tid == 0) qslot[1] = (int)atomicAdd(F.ctl + CW_QUEUE + 256 + rep_ * 16, (unsigned)MOE_W_BATCH); __syncthreads(); const int i0_ = __builtin_amdgcn_readfirstlane(qslot[1]); __syncthreads(); \
            moe_w_batch(args, i0_, (i0_ + MOE_W_BATCH < MOE_W_ITEMS ? i0_ + MOE_W_BATCH : MOE_W_ITEMS), tscr, F.wave, F.lane); __syncthreads(); i0_ < MOE_W_ITEMS; })
        REPS(PH_ATTN) {
        bool more_w = true;
        if ((((int)blockIdx.x >> 3) & 3) == 0) {
#pragma unroll 1
            while (more_w) more_w = MOE_W_POP();
        }
#pragma unroll 1
        for (;;) {
            if (F.tid == 0) qslot[0] = (int)atomicAdd(F.ctl + CW_QUEUE + rep_ * 128, 1u);
            __syncthreads();
            const int L = __builtin_amdgcn_readfirstlane(qslot[0]);
            __syncthreads();
            if (L >= 1024) break;
            if (rep_ == 1 && (PROBE_ATT_PART == 2 || PROBE_ATT_PART == 3)) continue;
            fa::nsa_unit((char*)lds_raw, ws, L, F.wave, rep_ == 1 ? PROBE_NSA_FLAGS : 0);
        }
        int ndil = 0;
#pragma unroll 1
        for (;;) {
            if (F.tid == 0) qslot[0] = (int)atomicAdd(F.ctl + CW_QUEUE + 64 + rep_ * 128, 1u);
            __syncthreads();
            const int L = __builtin_amdgcn_readfirstlane(qslot[0]);
            __syncthreads();
            if (L >= 1536) break;
            if (rep_ == 1 && (PROBE_ATT_PART == 1 || PROBE_ATT_PART == 3)) continue;
            fa::dil_unit((char*)lds_raw, ws, L, F.wave);
        }
#pragma unroll 1
        while (more_w) more_w = MOE_W_POP();
        }
#undef MOE_W_POP
        if (BOTH(PH_ATTN)) xcd_barrier(bar, tid_of(F.wave) == 0);
    }
    if (IN(PH_BRA)) { REFRAME();
        fa::dil_combine(ws, (F.vcu * NWAVES + F.wave) * 64 + F.lane, F.G * NWAVES * 64);
        xcd_barrier(bar, tid_of(F.wave) == 0);
        pg8::Gemm g{(const bf16_t*)(ws + WS_ONSAB), (const bf16_t*)(ws + WS_WBA), 1024, nullptr, (const bf16_t*)(ws + WS_ODILB), (const bf16_t*)(ws + WS_WBD), 512};
        pg8::StaticOrder S; S.init(T_ / 256, DM / 256, F.G, (int)blockIdx.x);
        pg8::EpiBr2 E{(bf16_t*)(ws + WS_MERGED), (const bf16_t*)(ws + WS_PROJ + PJ_GA), (const bf16_t*)(ws + WS_PROJ + PJ_GB)};
        REPS(PH_BRA) pg8::gemm_phase<pg8::EpiBr2, pg8::StaticOrder, false, false, true>(F.lds + RING_OFF, g, S, E, F.wave);
        if (BOTH(PH_BRA)) xcd_barrier(bar, tid_of(F.wave) == 0);
    }
    if (IN(PH_BRB)) { }
    if (IN(PH_WOUT)) {
        pg8::Gemm g{(const bf16_t*)(ws + WS_MERGED), (const bf16_t*)(ws + WS_WOUT), DM, nullptr};
        pg8::StaticOrder S; S.init(T_ / 256, DM / 256, F.G, (int)blockIdx.x);
        pg8::EpiWout E{(bf16_t*)(ws + WS_Z)};
        REPS(PH_WOUT) pg8::gemm_phase<pg8::EpiWout, pg8::StaticOrder, false>(F.lds + RING_OFF, g, S, E, F.wave);
        if (BOTH(PH_WOUT)) xcd_barrier(bar, tid_of(F.wave) == 0);
    }
    if (IN(PH_LN1)) { REFRAME(); p_ln1_router(F, args); if (BOTH(PH_LN1)) xcd_barrier(bar, tid_of(F.wave) == 0); }
    if (IN(PH_SCATTER)) { REFRAME(); p_scatter(F, args); if (BOTH(PH_SCATTER)) xcd_barrier(bar, tid_of(F.wave) == 0); }
    if (IN(PH_UP)) {
        const int ntiles = (int)__hip_atomic_load(F.ctl + CW_NTILES, __ATOMIC_RELAXED, __HIP_MEMORY_SCOPE_AGENT);
        pg8::Gemm g{(const bf16_t*)(ws + WS_HB), (const bf16_t*)(ws + WS_WUP), DM, (const int*)(ws + WS_ROUTE + 4 * 512 * 1024)};
        { LAS unsigned* tel = (LAS unsigned*)(F.lds + RING_BYTES); for (int i = F.tid; i < MOE_TILES; i += NWAVES * 64) tel[i] = F.ctl[CW_TILEEXP + i]; __syncthreads(); }
        pg8::ExpertOrder S; S.so.init(ntiles, 16, F.G, (int)blockIdx.x); S.tile_exp = (const LAS unsigned*)(F.lds + RING_BYTES);
        pg8::EpiSwigluT<true> E{(unsigned char*)(ws + WS_ACT), (const float*)(ws + WS_BUPP), 1.f / (W8_SCALE * F8_FUDGE)};
        REPS(PH_UP) pg8::gemm_phase<pg8::EpiSwigluT<true>, pg8::ExpertOrder, true, true>(F.lds + RING_OFF, g, S, E, F.wave);
#ifdef PROBE_NULL_UP
        { pg8::EpiNull EN; pg8::gemm_phase<pg8::EpiNull, pg8::ExpertOrder, true, true>(F.lds + RING_OFF, g, S, EN, F.wave); }
#endif
        if (BOTH(PH_UP)) xcd_barrier(bar, tid_of(F.wave) == 0);
    }
    if (IN(PH_DOWN)) {
        const int ntiles = (int)__hip_atomic_load(F.ctl + CW_NTILES, __ATOMIC_RELAXED, __HIP_MEMORY_SCOPE_AGENT);
        pg8::Gemm g{(const bf16_t*)(ws + WS_ACT), (const bf16_t*)(ws + WS_WDN), DM, nullptr};
        { LAS unsigned* tel = (LAS unsigned*)(F.lds + RING_BYTES); for (int i = F.tid; i < MOE_TILES; i += NWAVES * 64) tel[i] = F.ctl[CW_TILEEXP + i]; __syncthreads(); }
        pg8::ExpertOrder S; S.so.init(ntiles, 8, F.G, (int)blockIdx.x); S.tile_exp = (const LAS unsigned*)(F.lds + RING_BYTES);
        pg8::EpiDown E{(unsigned char*)(ws + WS_Y), args.in[19], (const float*)(ws + WS_ROUTE + 4 * 512 * 1024 + 544 * 1024), 1.f / (W8_SCALE * F8_FUDGE)};
        REPS(PH_DOWN) pg8::gemm_phase<pg8::EpiDown, pg8::ExpertOrder, false, true>(F.lds + RING_OFF, g, S, E, F.wave);
        if (BOTH(PH_DOWN)) xcd_barrier(bar, tid_of(F.wave) == 0);
    }
    if (IN(PH_FINAL)) { REFRAME(); REPS(PH_FINAL) p_final(F, args); }
#undef IN
#undef BOTH
}
static int g_grid = 0;
static void mk_launch(const Args& base, int lo, int hi, int li, hipStream_t stream) {
    Args a = base; a.ph_lo = lo; a.ph_hi = hi; a.li = li; a.pad = 0;
    hipLaunchKernelGGL(mk_fwd, dim3(g_grid), dim3(NWAVES * 64), LDS_BYTES, stream, a);
}
extern "C" void kernel_launch(void* const* d_in, const int* in_sizes, int n_in, void* d_out, int out_size, void* d_ws, size_t ws_size, hipStream_t stream) {
    if (g_grid == 0) {
        if (n_in != 22 || ws_size < WS_END) { fprintf(stderr, "kernel_launch: bad args n_in=%d ws=%zu need %zu\n", n_in, ws_size, (size_t)WS_END); g_grid = -1; return; }
        int dev = 0, cus = 0, per_cu = 0;
        if (hipGetDevice(&dev) != hipSuccess || hipDeviceGetAttribute(&cus, hipDeviceAttributeMultiprocessorCount, dev) != hipSuccess) { g_grid = -1; return; }
        if (hipFuncSetAttribute((const void*)mk_fwd, hipFuncAttributeMaxDynamicSharedMemorySize, LDS_BYTES) != hipSuccess) { fprintf(stderr, "hipFuncSetAttribute failed\n"); g_grid = -1; return; }
        if (hipOccupancyMaxActiveBlocksPerMultiprocessor(&per_cu, (const void*)mk_fwd, NWAVES * 64, LDS_BYTES) != hipSuccess || per_cu < 1) fprintf(stderr, "occupancy query: %d\n", per_cu);
        (void)hipGetLastError();
        g_grid = cus;
    }
    if (g_grid < 0) return;
    Args p{}; for (int i = 0; i < 22; ++i) p.in[i] = (const float*)d_in[i]; p.out = (float*)d_out; p.ws = (unsigned char*)d_ws;
    unsigned char* ws = p.ws;
    (void)hipMemsetAsync(ws + WS_CTL, 0, 1 * MiB, stream);
#ifndef MK_N_LAUNCHES
#define MK_N_LAUNCHES 1
#endif
    if (MK_N_LAUNCHES == 1) mk_launch(p, 0, PH_COUNT, 0, stream);
    else { mk_launch(p, PH_PROLOGUE, PH_INPROJ + 1, 0, stream); for (int ph = PH_COMPRESS; ph <= PH_FINAL; ++ph) mk_launch(p, ph, ph + 1, 1, stream); }
}
```
